# Optimizing an MI355X kernel written in HIP

```python
import math
import jax, jax.numpy as jnp
from jax import lax
import numpy as np

D_MODEL = 1024
BATCH = 4
SEQ = 4096
DEPTH = 1
DEC_BATCH = 128
DEC_SEQ = 8
PAST_LEN = 8192
PAGE_SIZE = 128

D_FF = 2816
CHUNK = 128
A_GROUPS = 4
A_GROUP_DIM = 128
A_WIDTH = A_GROUPS * A_GROUP_DIM
N_HEADS = 8
QK_NOPE = 64
QK_ROPE = 32
QK_HEAD = QK_NOPE + QK_ROPE
V_DIM = 64
Q_LORA = 384
KV_LORA = 256
ROPE_THETA = 10000.0
Q_BLOCK = 128
PLE_DIM = 256
EPS = 1e-6
IN_COLS = 2 * A_WIDTH + Q_LORA + KV_LORA + QK_ROPE + 2 * D_MODEL

kernel_name = 'hybrid_gmlp_mla_macaron_decode_step'


def rmsnorm(x, g):
    xf = x.astype(jnp.float32)
    y = xf * lax.rsqrt(jnp.mean(xf * xf, axis=-1, keepdims=True) + EPS)
    return (y * g.astype(jnp.float32)).astype(x.dtype)


def layernorm(x, g, b):
    xf = x.astype(jnp.float32)
    xc = xf - jnp.mean(xf, axis=-1, keepdims=True)
    y = xc * lax.rsqrt(jnp.mean(xc * xc, axis=-1, keepdims=True) + EPS)
    return (y * g.astype(jnp.float32) + b.astype(jnp.float32)).astype(x.dtype)


def swiglu(x, w_in, w_out):
    a, b = jnp.split(x @ w_in, 2, axis=-1)
    return (jax.nn.silu(a) * b) @ w_out


def rope_cos_sin(n_pos, offset, dtype):
    pos = jnp.arange(n_pos, dtype=jnp.float32) + offset
    inv_freq = ROPE_THETA ** (-jnp.arange(0, QK_ROPE, 2, dtype=jnp.float32) / QK_ROPE)
    ang = pos[:, None] * inv_freq[None, :]
    return jnp.cos(ang).astype(dtype), jnp.sin(ang).astype(dtype)


def apply_rope(x, cos, sin):
    x1, x2 = jnp.split(x, 2, axis=-1)
    return jnp.concatenate([x1 * cos - x2 * sin, x1 * sin + x2 * cos], axis=-1)


def chunk_spatial_mix(v, w_s, b_s):
    B, T, G, C = v.shape
    n_chunks = -(-T // CHUNK)
    pad = n_chunks * CHUNK - T
    vp = jnp.pad(v, ((0, 0), (0, pad), (0, 0), (0, 0))).reshape(B, n_chunks, CHUNK, G, C)
    causal = jnp.tril(jnp.ones((CHUNK, CHUNK), dtype=bool))
    w = jnp.where(causal[None], w_s, jnp.zeros_like(w_s))
    z = jnp.einsum('gts,bnsgc->bntgc', w, vp) + b_s.T[:, :, None]
    return z.reshape(B, n_chunks * CHUNK, G, C)[:, :T]


def expand_keys(c_kv, k_rope, w_ukv, g_k):
    kv = (c_kv @ w_ukv).reshape(c_kv.shape[:-1] + (N_HEADS, QK_NOPE + V_DIM))
    k_nope, v = kv[..., :QK_NOPE], kv[..., QK_NOPE:]
    k_pe = jnp.broadcast_to(k_rope[..., None, :], k_nope.shape[:-1] + (QK_ROPE,))
    k = rmsnorm(jnp.concatenate([k_nope, k_pe], axis=-1), g_k)
    return k, v


def attention(q, k, v, mask):
    s = jnp.einsum('...thd,...shd->...hts', q, k).astype(jnp.float32) * (QK_HEAD ** -0.5)
    s = jnp.where(mask, s, jnp.finfo(jnp.float32).min)
    p = jax.nn.softmax(s, axis=-1).astype(v.dtype)
    return jnp.einsum('...hts,...shd->...thd', p, v)


def prompt_attend(q, c_kv, k_rope, w_ukv, g_k):
    B, S = q.shape[0], q.shape[1]
    k, v = expand_keys(c_kv, k_rope, w_ukv, g_k)
    n_blocks = S // Q_BLOCK
    qb = q.reshape(B, n_blocks, Q_BLOCK, N_HEADS, QK_HEAD).transpose(1, 0, 2, 3, 4)
    k_pos = jnp.arange(S)

    def one_block(args):
        q_blk, j = args
        q_pos = j * Q_BLOCK + jnp.arange(Q_BLOCK)
        return attention(q_blk, k, v, k_pos[None, :] <= q_pos[:, None])

    o = lax.map(one_block, (qb, jnp.arange(n_blocks)))
    return o.transpose(1, 0, 2, 3, 4).reshape(B, S, N_HEADS, V_DIM)


def make_sample_attend(cache_ckv, cache_krope, page_table, layer):
    def attend(q, c_new, kr_new, w_ukv, g_k):
        def one_seq(args):
            q1, c1, kr1, pt = args
            past_c = cache_ckv[layer, pt].reshape(-1, KV_LORA).astype(c1.dtype)
            past_kr = cache_krope[layer, pt].reshape(-1, QK_ROPE).astype(kr1.dtype)
            c_all = jnp.concatenate([past_c, c1], axis=0)
            kr_all = jnp.concatenate([past_kr, kr1], axis=0)
            k, v = expand_keys(c_all, kr_all, w_ukv, g_k)
            n_past = past_c.shape[0]
            t_new = q1.shape[0]
            mask = jnp.arange(n_past + t_new)[None, :] <= (n_past + jnp.arange(t_new))[:, None]
            return attention(q1, k, v, mask)
        return lax.map(one_seq, (q, c_new, kr_new, page_table))
    return attend


def trunk_layer(x, p, offset, attend,
                ffn1_norm, ffn1_w_in, ffn1_w_out, mix_norm, w_in, qa_norm, kva_norm,
                w_uq, w_ukv, q_norm, k_norm, sgu_ln_g, sgu_ln_b, sgu_w_s, sgu_b_s,
                w_a_out, w_b_out, w_o, ffn2_norm, ffn2_w_in, ffn2_w_out,
                ple_norm, ple_w_gate, ple_w_proj):
    B, T, _ = x.shape
    h = x + 0.5 * swiglu(rmsnorm(x, ffn1_norm), ffn1_w_in, ffn1_w_out)
    n = rmsnorm(h, mix_norm)
    proj = n @ w_in
    s1 = 2 * A_WIDTH
    s2 = s1 + Q_LORA
    s3 = s2 + KV_LORA
    s4 = s3 + QK_ROPE
    uv, cq, ckv, kr, gates = jnp.split(proj, [s1, s2, s3, s4], axis=-1)
    u, v = jnp.split(jax.nn.gelu(uv), 2, axis=-1)
    vn = layernorm(v, sgu_ln_g, sgu_ln_b)
    z = chunk_spatial_mix(vn.reshape(B, T, A_GROUPS, A_GROUP_DIM), sgu_w_s, sgu_b_s)
    ya = (u * z.reshape(B, T, A_WIDTH)) @ w_a_out
    cos, sin = rope_cos_sin(T, offset, x.dtype)
    q = (rmsnorm(cq, qa_norm) @ w_uq).reshape(B, T, N_HEADS, QK_HEAD)
    q = jnp.concatenate([q[..., :QK_NOPE],
                         apply_rope(q[..., QK_NOPE:], cos[:, None, :], sin[:, None, :])], axis=-1)
    q = rmsnorm(q, q_norm)
    c_kv = rmsnorm(ckv, kva_norm)
    k_rope = apply_rope(kr, cos, sin)
    o = attend(q, c_kv, k_rope, w_ukv, k_norm)
    yb = o.reshape(B, T, N_HEADS * V_DIM) @ w_b_out
    g_a, g_b = jnp.split(gates, 2, axis=-1)
    h = h + (jax.nn.sigmoid(g_a) * ya + jax.nn.sigmoid(g_b) * yb) @ w_o
    h = h + 0.5 * swiglu(rmsnorm(h, ffn2_norm), ffn2_w_in, ffn2_w_out)
    h = h + jax.nn.sigmoid(rmsnorm(h, ple_norm) @ ple_w_gate) * (p @ ple_w_proj)
    return h, c_kv, k_rope, vn


def setup_inputs(seed: int = 0) -> dict:
    key = jax.random.key(seed)
    ks = jax.random.split(key, 32)
    f32 = jnp.float32
    n_pages = PAST_LEN // PAGE_SIZE
    n_used = DEC_BATCH * n_pages
    n_pool = n_used + n_used // 4

    def nrm(k, shape, scale=1.0):
        return jax.random.normal(k, shape, f32) * scale

    def gain(k, n):
        return 1.0 + 0.01 * jax.random.normal(k, (DEPTH, n), f32)

    page_table = jax.random.permutation(ks[4], n_pool)[:n_used].reshape(DEC_BATCH, n_pages).astype(jnp.int32)
    return {
        'x_prompt': nrm(ks[0], (BATCH, SEQ, D_MODEL)),
        'x_sample': nrm(ks[1], (DEC_BATCH, DEC_SEQ, D_MODEL)),
        'cache_ckv': nrm(ks[2], (DEPTH, n_pool, PAGE_SIZE, KV_LORA)),
        'cache_krope': nrm(ks[3], (DEPTH, n_pool, PAGE_SIZE, QK_ROPE)),
        'page_table': page_table,
        'p_prompt': nrm(ks[5], (DEPTH, BATCH, SEQ, PLE_DIM)),
        'p_sample': nrm(ks[6], (DEPTH, DEC_BATCH, DEC_SEQ, PLE_DIM)),
        'ffn1_norm': gain(ks[7], D_MODEL),
        'ffn1_w_in': nrm(ks[8], (DEPTH, D_MODEL, 2 * D_FF), D_MODEL ** -0.5),
        'ffn1_w_out': nrm(ks[9], (DEPTH, D_FF, D_MODEL), D_FF ** -0.5),
        'mix_norm': gain(ks[10], D_MODEL),
        'w_in': nrm(ks[11], (DEPTH, D_MODEL, IN_COLS), D_MODEL ** -0.5),
        'qa_norm': gain(ks[12], Q_LORA),
        'kva_norm': gain(ks[13], KV_LORA),
        'w_uq': nrm(ks[14], (DEPTH, Q_LORA, N_HEADS * QK_HEAD), Q_LORA ** -0.5),
        'w_ukv': nrm(ks[15], (DEPTH, KV_LORA, N_HEADS * (QK_NOPE + V_DIM)), KV_LORA ** -0.5),
        'q_norm': gain(ks[16], QK_HEAD),
        'k_norm': gain(ks[17], QK_HEAD),
        'sgu_ln_g': gain(ks[18], A_WIDTH),
        'sgu_ln_b': nrm(ks[19], (DEPTH, A_WIDTH), 0.01),
        'sgu_w_s': nrm(ks[20], (DEPTH, A_GROUPS, CHUNK, CHUNK), CHUNK ** -0.5),
        'sgu_b_s': 1.0 + nrm(ks[21], (DEPTH, A_GROUPS, CHUNK), 0.1),
        'w_a_out': nrm(ks[22], (DEPTH, A_WIDTH, D_MODEL), A_WIDTH ** -0.5),
        'w_b_out': nrm(ks[23], (DEPTH, N_HEADS * V_DIM, D_MODEL), (N_HEADS * V_DIM) ** -0.5),
        'w_o': nrm(ks[24], (DEPTH, D_MODEL, D_MODEL), D_MODEL ** -0.5),
        'ffn2_norm': gain(ks[25], D_MODEL),
        'ffn2_w_in': nrm(ks[26], (DEPTH, D_MODEL, 2 * D_FF), D_MODEL ** -0.5),
        'ffn2_w_out': nrm(ks[27], (DEPTH, D_FF, D_MODEL), D_FF ** -0.5),
        'ple_norm': gain(ks[28], D_MODEL),
        'ple_w_gate': nrm(ks[29], (DEPTH, D_MODEL, D_MODEL), D_MODEL ** -0.5),
        'ple_w_proj': nrm(ks[30], (DEPTH, PLE_DIM, D_MODEL), PLE_DIM ** -0.5),
    }


def reference(x_prompt, x_sample, cache_ckv, cache_krope, page_table, p_prompt, p_sample,
              ffn1_norm, ffn1_w_in, ffn1_w_out, mix_norm, w_in, qa_norm, kva_norm,
              w_uq, w_ukv, q_norm, k_norm, sgu_ln_g, sgu_ln_b, sgu_w_s, sgu_b_s,
              w_a_out, w_b_out, w_o, ffn2_norm, ffn2_w_in, ffn2_w_out,
              ple_norm, ple_w_gate, ple_w_proj):
    y_prompt = x_prompt
    y_sample = x_sample
    ckv_p, kr_p, ckv_s, kr_s, v_s = [], [], [], [], []
    for i in range(DEPTH):
        lw = (ffn1_norm[i], ffn1_w_in[i], ffn1_w_out[i], mix_norm[i], w_in[i], qa_norm[i],
              kva_norm[i], w_uq[i], w_ukv[i], q_norm[i], k_norm[i], sgu_ln_g[i], sgu_ln_b[i],
              sgu_w_s[i], sgu_b_s[i], w_a_out[i], w_b_out[i], w_o[i], ffn2_norm[i],
              ffn2_w_in[i], ffn2_w_out[i], ple_norm[i], ple_w_gate[i], ple_w_proj[i])
        y_prompt, c_p, k_p, _ = trunk_layer(y_prompt, p_prompt[i], 0, prompt_attend, *lw)
        sample_attend = make_sample_attend(cache_ckv, cache_krope, page_table, i)
        y_sample, c_s, k_s, vn_s = trunk_layer(y_sample, p_sample[i], PAST_LEN, sample_attend, *lw)
        ckv_p.append(c_p)
        kr_p.append(k_p)
        ckv_s.append(c_s)
        kr_s.append(k_s)
        v_s.append(vn_s)
    return (y_prompt, y_sample, jnp.stack(ckv_p), jnp.stack(kr_p),
            jnp.stack(ckv_s), jnp.stack(kr_s), jnp.stack(v_s))
```

```cpp
#include <hip/hip_runtime.h>
#include <cstdio>
#include <cstdint>

#define GAS __attribute__((address_space(1)))
#define LAS __attribute__((address_space(3)))
typedef unsigned short bf16;
typedef short bf16x8 __attribute__((ext_vector_type(8)));
typedef float f32x4 __attribute__((ext_vector_type(4)));
typedef unsigned u32x4 __attribute__((ext_vector_type(4)));
typedef unsigned u32x2 __attribute__((ext_vector_type(2)));

constexpr int DM = 1024, TP = 16384, TS = 1024, T = TP + TS, SEQ = 4096, DFF = 2816, NFF = 2 * DFF;
constexpr int AW = 512, QL = 384, KVL = 256, ROPE = 32, NH = 8, QKH = 96, NOPE = 64, VD = 64, PLE = 256;
constexpr int INC = 3744, INP = 3840;
constexpr int PAST = 8192, PAGE = 128, NPAGES = 64, DECB = 128, DECS = 8;
constexpr float EPS = 1e-6f;
constexpr int NWAVES = 8, NTHREADS = 512;

constexpr size_t O_Y = 0, O_CKVP = (size_t)T * DM, O_KRP = O_CKVP + (size_t)TP * KVL, O_CKVS = O_KRP + (size_t)TP * ROPE,
                 O_KRS = O_CKVS + (size_t)TS * KVL, O_VNS = O_KRS + (size_t)TS * ROPE, O_END = O_VNS + (size_t)TS * AW;

constexpr size_t MiB = 1u << 20;
constexpr size_t WS_CTL = 0, CTL_ZERO_BYTES = 1 * MiB;
constexpr size_t CTL_BAR_WORD = 4096;
constexpr size_t CTL_SSH1 = 262144, CTL_SSH2 = CTL_SSH1 + 131072, CTL_SSH3 = CTL_SSH2 + 131072;
constexpr size_t WS_W1T = 2 * MiB, WS_W2T = 14 * MiB, WS_WINT = 20 * MiB, WS_WUQT = 28 * MiB, WS_WUKVT = 29 * MiB, WS_WAT = 30 * MiB,
                 WS_WBT = 31 * MiB, WS_WOT = 32 * MiB, WS_W3T = 34 * MiB, WS_W4T = 46 * MiB, WS_WGT = 52 * MiB, WS_WPT = 54 * MiB;
constexpr size_t WS_XB = 64 * MiB, WS_HB = 100 * MiB, WS_ACT = 136 * MiB, WS_U = 232 * MiB, WS_V = 250 * MiB, WS_VN = 268 * MiB,
                 WS_RAW = 286 * MiB, WS_SG = 338 * MiB, WS_CKV = 408 * MiB, WS_KR = 418 * MiB, WS_CQN = 420 * MiB, WS_UZ = 434 * MiB,
                 WS_QRAW = 452 * MiB, WS_Q = 478 * MiB, WS_KVR = 504 * MiB, WS_KN = 538 * MiB, WS_O = 564 * MiB, WS_MXF = 582 * MiB,
                 WS_MX = 650 * MiB, WS_PP = 684 * MiB, WS_PB = 752 * MiB, WS_SSX = 762 * MiB, WS_KPAST = 1024 * MiB, WS_END = 3072 * MiB;

constexpr int LDS_BYTES = 147456;

__device__ __forceinline__ unsigned f2bf(float f) { unsigned u = __builtin_bit_cast(unsigned, f); return (u + 0x7fffu + ((u >> 16) & 1u)) >> 16; }
__device__ __forceinline__ unsigned pk2(float lo, float hi) { return f2bf(lo) | (f2bf(hi) << 16); }
__device__ __forceinline__ float bf2f(unsigned b) { return __builtin_bit_cast(float, b << 16); }
__device__ __forceinline__ float bflo(unsigned w) { return __builtin_bit_cast(float, w << 16); }
__device__ __forceinline__ float bfhi(unsigned w) { return __builtin_bit_cast(float, w & 0xffff0000u); }
__device__ __forceinline__ float wave_sum(float v) {
#pragma unroll
    for (int o = 1; o < 64; o <<= 1) v += __shfl_xor(v, o);
    return v;
}
__device__ __forceinline__ float sigmoidf_(float x) { return 1.0f / (1.0f + __expf(-x)); }
__device__ __forceinline__ float gelu_tanh(float x) {
    const float y = 0.7978845608028654f * (x + 0.044715f * x * x * x);
    const float e = __expf(2.0f * y);
    const float th = 1.0f - 2.0f / (e + 1.0f);
    return 0.5f * x * (1.0f + th);
}
__device__ __forceinline__ void unpack8(const u32x4 w, float* f) {
    f[0] = bflo(w.x); f[1] = bfhi(w.x); f[2] = bflo(w.y); f[3] = bfhi(w.y); f[4] = bflo(w.z); f[5] = bfhi(w.z); f[6] = bflo(w.w); f[7] = bfhi(w.w);
}

#define XB_TMO      128
#define XB_XCNT(j)  (256  + 64 * (j))
#define XB_XSUB(j)  (1280 + 64 * (j))
#define XB_XGEN(j)  (2304 + 64 * (j))
#define XB_TOP      3328
#define XB_TOPGEN   3392
#define XCD_BAR_WORDS 3456
#define XB_SPIN_CAP (1u << 21)
__device__ __forceinline__ unsigned xb_ld(unsigned* p)              { return __hip_atomic_load(p, __ATOMIC_RELAXED, __HIP_MEMORY_SCOPE_AGENT); }
__device__ __forceinline__ unsigned xb_add(unsigned* p, unsigned v) { return __hip_atomic_fetch_add(p, v, __ATOMIC_RELAXED, __HIP_MEMORY_SCOPE_AGENT); }
__device__ __forceinline__ unsigned xb_xcc_id() { return (unsigned)__builtin_amdgcn_s_getreg((3 << 11) | 20) & 0xFu; }
#define XB_SPIN(cond, bar) do { unsigned _sp = 0; while (cond) { __builtin_amdgcn_s_sleep(1); \
    if ((++_sp & 255u) == 0u) { if (xb_ld(&(bar)[XB_TMO])) break; if (_sp > XB_SPIN_CAP) { atomicAdd(&(bar)[XB_TMO], 1u); break; } } } } while (0)
struct XcdBarrier { unsigned* bar; unsigned x; volatile LAS unsigned* st; };
__device__ __forceinline__ XcdBarrier xcd_barrier_post(unsigned* bar, volatile LAS unsigned* st) {
    XcdBarrier b; b.bar = bar; b.x = xb_xcc_id(); b.st = st;
    if (threadIdx.x == 0) (void)xb_add(&bar[XB_XCNT(b.x)], 1u);
    return b;
}
__device__ __forceinline__ void xcd_barrier_complete(unsigned* bar, unsigned x, unsigned& nloc, unsigned& nx) {
    const unsigned G = gridDim.x * gridDim.y * gridDim.z;
    unsigned sum, cnt, mine, sp = 0u;
    for (;;) {
        sum = 0u; cnt = 0u; mine = 0u;
#pragma unroll
        for (unsigned j = 0; j < 16; ++j) { const unsigned c = xb_ld(&bar[XB_XCNT(j)]); sum += c; cnt += (c > 0u) ? 1u : 0u; mine = (j == x) ? c : mine; }
        if (sum == G) break;
        __builtin_amdgcn_s_sleep(1);
        if ((++sp & 255u) == 0u) { if (xb_ld(&bar[XB_TMO])) break; if (sp > XB_SPIN_CAP) { atomicAdd(&bar[XB_TMO], 1u); break; } }
    }
    nloc = mine > 0u ? mine : 1u; nx = cnt > 0u ? cnt : 1u;
}
__device__ __forceinline__ void xcd_barrier(const XcdBarrier& b) {
    asm volatile("s_waitcnt vmcnt(0)" ::: "memory");
    __syncthreads();
    if (threadIdx.x == 0) {
        unsigned* bar = b.bar;
        __builtin_amdgcn_s_waitcnt(0);
        unsigned nloc = b.st[0], nx = b.st[1];
        if (nloc == 0u) { xcd_barrier_complete(bar, b.x, nloc, nx); b.st[0] = nloc; b.st[1] = nx; }
        const unsigned old = xb_add(&bar[XB_XSUB(b.x)], 1u);
        const unsigned gen = old / nloc;
        if (old + 1u == (gen + 1u) * nloc) {
            __builtin_amdgcn_fence(__ATOMIC_RELEASE, "agent");
            asm volatile("s_waitcnt vmcnt(0)" ::: "memory");
            const unsigned og = xb_add(&bar[XB_TOP], 1u);
            const unsigned tg = og / nx;
            if (og + 1u == (tg + 1u) * nx) xb_add(&bar[XB_TOPGEN], 1u);
            else XB_SPIN(xb_ld(&bar[XB_TOPGEN]) == tg, bar);
            __builtin_amdgcn_fence(__ATOMIC_ACQUIRE, "agent");
            xb_add(&bar[XB_XGEN(b.x)], 1u);
            asm volatile("s_waitcnt vmcnt(0)" ::: "memory");
        } else {
            XB_SPIN(xb_ld(&bar[XB_XGEN(b.x)]) == gen, bar);
            __builtin_amdgcn_fence(__ATOMIC_ACQUIRE, "agent");
            asm volatile("s_waitcnt vmcnt(0)" ::: "memory");
        }
    }
    __syncthreads();
}

struct Args {
    const float* in[31]; const int* pt; float* out; unsigned char* ws;
};

struct ABf16 {
    const bf16* A; int lda;
    __device__ __forceinline__ bf16x8 operator()(int row, int k) const { return *(const bf16x8*)(A + (size_t)row * lda + k); }
};
struct ACacheF32 {
    const float* cache; const int* pt;
    __device__ __forceinline__ bf16x8 operator()(int row, int k) const {
        const int seq = row >> 13, j = row & 8191; const int page = pt[seq * NPAGES + (j >> 7)];
        const float* p = cache + ((size_t)page * PAGE + (j & 127)) * KVL + k;
        const f32x4 a = *(const f32x4*)p, b = *(const f32x4*)(p + 4);
        u32x4 w; w.x = pk2(a.x, a.y); w.y = pk2(a.z, a.w); w.z = pk2(b.x, b.y); w.w = pk2(b.z, b.w);
        return __builtin_bit_cast(bf16x8, w);
    }
};

template <bool PAIR, class AL, class Epi>
__device__ __forceinline__ void sgemm(const AL& A, const bf16* __restrict__ Bt, int M, int N, int K, const Epi& E, int gw, int ngw, int lane) {
    const int fr = lane & 15, fq = lane >> 4;
    const int nRT = M / 32, nCG = N / 64;
    const long nitems = (long)nRT * nCG;
    for (long it = gw; it < nitems; it += ngw) {
        const int rt = (int)(it % nRT), cg = (int)(it / nRT);
        const int r0 = rt * 32;
        int cb0, cb1, cb2, cb3, oc0, oc1;
        if (PAIR) { const int pn = cg >> 2, g = cg & 3; cb0 = 256 * pn + 32 * g; cb1 = cb0 + 16; cb2 = cb0 + 128; cb3 = cb0 + 144; oc0 = 128 * pn + 32 * g; oc1 = oc0 + 16; }
        else { cb0 = 64 * cg; cb1 = cb0 + 16; cb2 = cb0 + 32; cb3 = cb0 + 48; oc0 = 0; oc1 = 0; }
        f32x4 acc[2][4];
#pragma unroll
        for (int i = 0; i < 2; ++i)
#pragma unroll
            for (int j = 0; j < 4; ++j) acc[i][j] = (f32x4){0.f, 0.f, 0.f, 0.f};
        const bf16* b0p = Bt + (size_t)(cb0 + fr) * K + 8 * fq;
        const bf16* b1p = Bt + (size_t)(cb1 + fr) * K + 8 * fq;
        const bf16* b2p = Bt + (size_t)(cb2 + fr) * K + 8 * fq;
        const bf16* b3p = Bt + (size_t)(cb3 + fr) * K + 8 * fq;
        for (int k = 0; k < K; k += 32) {
            const bf16x8 a0 = A(r0 + fr, k + 8 * fq), a1 = A(r0 + 16 + fr, k + 8 * fq);
            const bf16x8 b0 = *(const bf16x8*)(b0p + k), b1 = *(const bf16x8*)(b1p + k), b2 = *(const bf16x8*)(b2p + k), b3 = *(const bf16x8*)(b3p + k);
            acc[0][0] = __builtin_amdgcn_mfma_f32_16x16x32_bf16(b0, a0, acc[0][0], 0, 0, 0);
            acc[0][1] = __builtin_amdgcn_mfma_f32_16x16x32_bf16(b1, a0, acc[0][1], 0, 0, 0);
            acc[0][2] = __builtin_amdgcn_mfma_f32_16x16x32_bf16(b2, a0, acc[0][2], 0, 0, 0);
            acc[0][3] = __builtin_amdgcn_mfma_f32_16x16x32_bf16(b3, a0, acc[0][3], 0, 0, 0);
            acc[1][0] = __builtin_amdgcn_mfma_f32_16x16x32_bf16(b0, a1, acc[1][0], 0, 0, 0);
            acc[1][1] = __builtin_amdgcn_mfma_f32_16x16x32_bf16(b1, a1, acc[1][1], 0, 0, 0);
            acc[1][2] = __builtin_amdgcn_mfma_f32_16x16x32_bf16(b2, a1, acc[1][2], 0, 0, 0);
            acc[1][3] = __builtin_amdgcn_mfma_f32_16x16x32_bf16(b3, a1, acc[1][3], 0, 0, 0);
        }
#pragma unroll
        for (int i = 0; i < 2; ++i) {
            const int row = r0 + 16 * i + fr; float ss = 0.f;
            if constexpr (PAIR) { E.pair(row, oc0 + 4 * fq, acc[i][0], acc[i][2]); E.pair(row, oc1 + 4 * fq, acc[i][1], acc[i][3]); }
            else { ss += E.quad(row, cb0 + 4 * fq, acc[i][0]); ss += E.quad(row, cb1 + 4 * fq, acc[i][1]); ss += E.quad(row, cb2 + 4 * fq, acc[i][2]); ss += E.quad(row, cb3 + 4 * fq, acc[i][3]); }
            if constexpr (Epi::NEED_SS) { ss += __shfl_xor(ss, 16); ss += __shfl_xor(ss, 32); if (fq == 0) E.rowsum(row, ss); }
        }
    }
}

__device__ __forceinline__ void st_bf4(bf16* p, float a, float b, float c, float d) { u32x2 w; w.x = pk2(a, b); w.y = pk2(c, d); *(u32x2*)p = w; }

struct EpiSwiglu {
    static constexpr bool NEED_SS = false;
    bf16* ACT; const float* ss;
    __device__ __forceinline__ void pair(int row, int pcol, const f32x4& a, const f32x4& b) const {
        const float rinv = rsqrtf(ss[row] * (1.0f / DM) + EPS); float o[4];
#pragma unroll
        for (int e = 0; e < 4; ++e) { const float x = a[e] * rinv, y = b[e] * rinv; o[e] = x * sigmoidf_(x) * y; }
        st_bf4(ACT + (size_t)row * DFF + pcol, o[0], o[1], o[2], o[3]);
    }
    __device__ __forceinline__ float quad(int, int, const f32x4&) const { return 0.f; }
    __device__ __forceinline__ void rowsum(int, float) const {}
};
struct EpiResid {
    static constexpr bool NEED_SS = true;
    const float* bp; const float* bs; float* Y; bf16* HB; float* ssout; float scale;
    __device__ __forceinline__ float quad(int row, int col, const f32x4& v) const {
        const float* b = (row < TP) ? bp + (size_t)row * DM + col : bs + (size_t)(row - TP) * DM + col;
        const f32x4 h = *(const f32x4*)b + v * scale;
        *(f32x4*)(Y + (size_t)row * DM + col) = h;
        st_bf4(HB + (size_t)row * DM + col, h[0], h[1], h[2], h[3]);
        return (h[0] * h[0] + h[1] * h[1]) + (h[2] * h[2] + h[3] * h[3]);
    }
    __device__ __forceinline__ void rowsum(int row, float s) const { atomicAdd(ssout + row, s); }
    __device__ __forceinline__ void pair(int, int, const f32x4&, const f32x4&) const {}
};
struct EpiIn {
    static constexpr bool NEED_SS = false;
    bf16* U; bf16* V; float* RAW; bf16* SG; const float* ss;
    __device__ __forceinline__ float quad(int row, int col, const f32x4& v) const {
        const float rinv = rsqrtf(ss[row] * (1.0f / DM) + EPS);
        const f32x4 x = v * rinv;
        if (col < 512) st_bf4(U + (size_t)row * AW + col, gelu_tanh(x[0]), gelu_tanh(x[1]), gelu_tanh(x[2]), gelu_tanh(x[3]));
        else if (col < 1024) st_bf4(V + (size_t)row * AW + (col - 512), gelu_tanh(x[0]), gelu_tanh(x[1]), gelu_tanh(x[2]), gelu_tanh(x[3]));
        else if (col < 1792) *(f32x4*)(RAW + (size_t)row * 768 + (col - 1024)) = x;
        else st_bf4(SG + (size_t)row * 2048 + (col - 1792), sigmoidf_(x[0]), sigmoidf_(x[1]), sigmoidf_(x[2]), sigmoidf_(x[3]));
        return 0.f;
    }
    __device__ __forceinline__ void rowsum(int, float) const {}
    __device__ __forceinline__ void pair(int, int, const f32x4&, const f32x4&) const {}
};
struct EpiBf {
    static constexpr bool NEED_SS = false;
    bf16* O; int ldc;
    __device__ __forceinline__ float quad(int row, int col, const f32x4& v) const { st_bf4(O + (size_t)row * ldc + col, v[0], v[1], v[2], v[3]); return 0.f; }
    __device__ __forceinline__ void rowsum(int, float) const {}
    __device__ __forceinline__ void pair(int, int, const f32x4&, const f32x4&) const {}
};
struct EpiF32 {
    static constexpr bool NEED_SS = false;
    float* O; int ldc;
    __device__ __forceinline__ float quad(int row, int col, const f32x4& v) const { *(f32x4*)(O + (size_t)row * ldc + col) = v; return 0.f; }
    __device__ __forceinline__ void rowsum(int, float) const {}
    __device__ __forceinline__ void pair(int, int, const f32x4&, const f32x4&) const {}
};
struct EpiGateA {
    static constexpr bool NEED_SS = false;
    float* MXF; const bf16* SG;
    __device__ __forceinline__ float quad(int row, int col, const f32x4& v) const {
        const u32x2 g = *(const u32x2*)(SG + (size_t)row * 2048 + col);
        f32x4 o; o[0] = bflo(g.x) * v[0]; o[1] = bfhi(g.x) * v[1]; o[2] = bflo(g.y) * v[2]; o[3] = bfhi(g.y) * v[3];
        *(f32x4*)(MXF + (size_t)row * DM + col) = o; return 0.f;
    }
    __device__ __forceinline__ void rowsum(int, float) const {}
    __device__ __forceinline__ void pair(int, int, const f32x4&, const f32x4&) const {}
};
struct EpiGateB {
    static constexpr bool NEED_SS = false;
    const float* MXF; const bf16* SG; bf16* MX;
    __device__ __forceinline__ float quad(int row, int col, const f32x4& v) const {
        const u32x2 g = *(const u32x2*)(SG + (size_t)row * 2048 + 1024 + col);
        const f32x4 m = *(const f32x4*)(MXF + (size_t)row * DM + col);
        st_bf4(MX + (size_t)row * DM + col, m[0] + bflo(g.x) * v[0], m[1] + bfhi(g.x) * v[1], m[2] + bflo(g.y) * v[2], m[3] + bfhi(g.y) * v[3]);
        return 0.f;
    }
    __device__ __forceinline__ void rowsum(int, float) const {}
    __device__ __forceinline__ void pair(int, int, const f32x4&, const f32x4&) const {}
};
struct EpiPle {
    static constexpr bool NEED_SS = false;
    float* Y; const float* PP; const float* ss;
    __device__ __forceinline__ float quad(int row, int col, const f32x4& v) const {
        const float rinv = rsqrtf(ss[row] * (1.0f / DM) + EPS);
        const f32x4 h = *(const f32x4*)(Y + (size_t)row * DM + col), p = *(const f32x4*)(PP + (size_t)row * DM + col);
        f32x4 o;
#pragma unroll
        for (int e = 0; e < 4; ++e) o[e] = h[e] + sigmoidf_(v[e] * rinv) * p[e];
        *(f32x4*)(Y + (size_t)row * DM + col) = o; return 0.f;
    }
    __device__ __forceinline__ void rowsum(int, float) const {}
    __device__ __forceinline__ void pair(int, int, const f32x4&, const f32x4&) const {}
};

template <int MODE> __device__ __forceinline__ int cmap(int n) {
    if (MODE == 0) return n;
    if (MODE == 1) { const int p = n >> 8, j = n & 255; return j < 128 ? 128 * p + j : DFF + 128 * p + (j - 128); }
    if (n < 1024) return n;
    if (n < 1280) return 1408 + (n - 1024);
    if (n < 1664) return 1024 + (n - 1280);
    if (n < 1696) return n;
    if (n < 1792) return -1;
    return 1696 + (n - 1792);
}
template <int MODE> __device__ __forceinline__ void conv_w(const float* __restrict__ src, int K, int Nsrc, bf16* __restrict__ dst, int Ndst, const float* __restrict__ gain, long gt, long ngt) {
    const long total = (long)K * Ndst;
    for (long i = gt; i < total; i += ngt) {
        const int k = (int)(i / Ndst), n = (int)(i % Ndst);
        const int c = cmap<MODE>(n);
        float v = 0.f;
        if (c >= 0) { v = src[(size_t)k * Nsrc + c]; if (gain) v *= gain[k]; }
        dst[(size_t)n * K + k] = (bf16)f2bf(v);
    }
}

__device__ __forceinline__ void rope_cs(int pos, int i, float& c, float& s) {
    const double inv = exp2(-(double)i * (13.287712379549449 / 16.0));
    const double ang = (double)((float)pos * (float)inv);
    c = (float)cos(ang); s = (float)sin(ang);
}
__device__ __forceinline__ int tok_pos(int r) { return r < TP ? (r & (SEQ - 1)) : PAST + ((r - TP) & (DECS - 1)); }

__global__ void __launch_bounds__(NTHREADS, 2) fwd(Args a) {
    extern __shared__ __attribute__((aligned(16))) unsigned char lds[];
    const int tid = threadIdx.x, lane = tid & 63, wave = __builtin_amdgcn_readfirstlane(tid >> 6);
    const int G = gridDim.x;
    const int gw = blockIdx.x * NWAVES + wave, ngw = G * NWAVES;
    const long gt = (long)blockIdx.x * NTHREADS + tid, ngt = (long)G * NTHREADS;
    unsigned char* ws = a.ws;
    volatile LAS unsigned* MISC = (volatile LAS unsigned*)((LAS unsigned char*)lds + 131072);
    if (tid < 32) MISC[tid] = 0u;
    __syncthreads();
    XcdBarrier bar = xcd_barrier_post((unsigned*)(ws + WS_CTL) + CTL_BAR_WORD, MISC + 8);
#define GRID_BAR() xcd_barrier(bar)

    const float* x_p = a.in[0]; const float* x_s = a.in[1]; const float* cache_ckv = a.in[2]; const float* cache_kr = a.in[3]; const int* pt = a.pt;
    const float* p_p = a.in[5]; const float* p_s = a.in[6];
    const float* ffn1_norm = a.in[7]; const float* ffn1_w_in = a.in[8]; const float* ffn1_w_out = a.in[9]; const float* mix_norm = a.in[10]; const float* w_in = a.in[11];
    const float* qa_norm = a.in[12]; const float* kva_norm = a.in[13]; const float* w_uq = a.in[14]; const float* w_ukv = a.in[15]; const float* q_norm = a.in[16]; const float* k_norm = a.in[17];
    const float* sgu_g = a.in[18]; const float* sgu_b = a.in[19]; const float* sgu_ws = a.in[20]; const float* sgu_bs = a.in[21];
    const float* w_a_out = a.in[22]; const float* w_b_out = a.in[23]; const float* w_o = a.in[24];
    const float* ffn2_norm = a.in[25]; const float* ffn2_w_in = a.in[26]; const float* ffn2_w_out = a.in[27];
    const float* ple_norm = a.in[28]; const float* ple_w_gate = a.in[29]; const float* ple_w_proj = a.in[30];
    float* out = a.out;
    bf16* W1T = (bf16*)(ws + WS_W1T); bf16* W2T = (bf16*)(ws + WS_W2T); bf16* WINT = (bf16*)(ws + WS_WINT); bf16* WUQT = (bf16*)(ws + WS_WUQT); bf16* WUKVT = (bf16*)(ws + WS_WUKVT);
    bf16* WAT = (bf16*)(ws + WS_WAT); bf16* WBT = (bf16*)(ws + WS_WBT); bf16* WOT = (bf16*)(ws + WS_WOT); bf16* W3T = (bf16*)(ws + WS_W3T); bf16* W4T = (bf16*)(ws + WS_W4T);
    bf16* WGT = (bf16*)(ws + WS_WGT); bf16* WPT = (bf16*)(ws + WS_WPT);
    bf16* XB = (bf16*)(ws + WS_XB); bf16* HB = (bf16*)(ws + WS_HB); bf16* ACT = (bf16*)(ws + WS_ACT); bf16* Ub = (bf16*)(ws + WS_U); bf16* Vb = (bf16*)(ws + WS_V); bf16* VN = (bf16*)(ws + WS_VN);
    float* RAW = (float*)(ws + WS_RAW); bf16* SG = (bf16*)(ws + WS_SG); bf16* CKV = (bf16*)(ws + WS_CKV); bf16* KR = (bf16*)(ws + WS_KR); bf16* CQN = (bf16*)(ws + WS_CQN); bf16* UZ = (bf16*)(ws + WS_UZ);
    bf16* QRAW = (bf16*)(ws + WS_QRAW); bf16* Qn = (bf16*)(ws + WS_Q); bf16* KVR = (bf16*)(ws + WS_KVR); bf16* KN = (bf16*)(ws + WS_KN); bf16* Ob = (bf16*)(ws + WS_O);
    float* MXF = (float*)(ws + WS_MXF); bf16* MX = (bf16*)(ws + WS_MX); float* PP = (float*)(ws + WS_PP); bf16* PB = (bf16*)(ws + WS_PB); float* SSX = (float*)(ws + WS_SSX);
    bf16* KPAST = (bf16*)(ws + WS_KPAST);
    float* SSH1 = (float*)(ws + CTL_SSH1); float* SSH2 = (float*)(ws + CTL_SSH2); float* SSH3 = (float*)(ws + CTL_SSH3);
    float* Y = out + O_Y;

    conv_w<1>(ffn1_w_in, DM, NFF, W1T, NFF, ffn1_norm, gt, ngt);
    conv_w<0>(ffn1_w_out, DFF, DM, W2T, DM, nullptr, gt, ngt);
    conv_w<2>(w_in, DM, INC, WINT, INP, mix_norm, gt, ngt);
    conv_w<0>(w_uq, QL, NH * QKH, WUQT, NH * QKH, nullptr, gt, ngt);
    conv_w<0>(w_ukv, KVL, NH * 128, WUKVT, NH * 128, nullptr, gt, ngt);
    conv_w<0>(w_a_out, AW, DM, WAT, DM, nullptr, gt, ngt);
    conv_w<0>(w_b_out, AW, DM, WBT, DM, nullptr, gt, ngt);
    conv_w<0>(w_o, DM, DM, WOT, DM, nullptr, gt, ngt);
    conv_w<1>(ffn2_w_in, DM, NFF, W3T, NFF, ffn2_norm, gt, ngt);
    conv_w<0>(ffn2_w_out, DFF, DM, W4T, DM, nullptr, gt, ngt);
    conv_w<0>(ple_w_gate, DM, DM, WGT, DM, ple_norm, gt, ngt);
    conv_w<0>(ple_w_proj, PLE, DM, WPT, DM, nullptr, gt, ngt);
    for (int r = gw; r < T; r += ngw) {
        const float* xr = (r < TP) ? x_p + (size_t)r * DM : x_s + (size_t)(r - TP) * DM;
        float s = 0.f;
#pragma unroll
        for (int j = 0; j < 4; ++j) { const f32x4 v = *(const f32x4*)(xr + 256 * j + 4 * lane); s += (v[0] * v[0] + v[1] * v[1]) + (v[2] * v[2] + v[3] * v[3]);
            st_bf4(XB + (size_t)r * DM + 256 * j + 4 * lane, v[0], v[1], v[2], v[3]); }
        s = wave_sum(s); if (lane == 0) SSX[r] = s;
        const float* pr = (r < TP) ? p_p + (size_t)r * PLE : p_s + (size_t)(r - TP) * PLE;
        const f32x4 pv = *(const f32x4*)(pr + 4 * lane); st_bf4(PB + (size_t)r * PLE + 4 * lane, pv[0], pv[1], pv[2], pv[3]);
    }
    GRID_BAR();

    { ABf16 A{XB, DM}; EpiSwiglu E{ACT, SSX}; sgemm<true>(A, W1T, T, NFF, DM, E, gw, ngw, lane); }
    GRID_BAR();
    { ABf16 A{ACT, DFF}; EpiResid E{x_p, x_s, Y, HB, SSH1, 0.5f}; sgemm<false>(A, W2T, T, DM, DFF, E, gw, ngw, lane); }
    GRID_BAR();
    { ABf16 A{HB, DM}; EpiIn E{Ub, Vb, RAW, SG, SSH1}; sgemm<false>(A, WINT, T, INP, DM, E, gw, ngw, lane); }
    { ABf16 A{PB, PLE}; EpiF32 E{PP, DM}; sgemm<false>(A, WPT, T, DM, PLE, E, gw, ngw, lane); }
    { ACacheF32 A{cache_ckv, pt}; EpiBf E{KPAST, 1024}; sgemm<false>(A, WUKVT, DECB * PAST, 1024, KVL, E, gw, ngw, lane); }
    GRID_BAR();

    for (int r = gw; r < T; r += ngw) {
        const float* raw = RAW + (size_t)r * 768;
        {
            const f32x4 v = *(const f32x4*)(raw + 4 * lane);
            const float ss = wave_sum((v[0] * v[0] + v[1] * v[1]) + (v[2] * v[2] + v[3] * v[3]));
            const float rinv = rsqrtf(ss * (1.0f / KVL) + EPS);
            const f32x4 g = *(const f32x4*)(kva_norm + 4 * lane);
            const f32x4 c = v * rinv * g;
            float* o = (r < TP) ? out + O_CKVP + (size_t)r * KVL : out + O_CKVS + (size_t)(r - TP) * KVL;
            *(f32x4*)(o + 4 * lane) = c;
            st_bf4(CKV + (size_t)r * KVL + 4 * lane, c[0], c[1], c[2], c[3]);
        }
        {
            if (lane < 16) {
                const float x1 = raw[640 + lane], x2 = raw[656 + lane]; float c, s; rope_cs(tok_pos(r), lane, c, s);
                const float o1 = x1 * c - x2 * s, o2 = x1 * s + x2 * c;
                float* o = (r < TP) ? out + O_KRP + (size_t)r * ROPE : out + O_KRS + (size_t)(r - TP) * ROPE;
                o[lane] = o1; o[16 + lane] = o2;
                KR[(size_t)r * ROPE + lane] = (bf16)f2bf(o1); KR[(size_t)r * ROPE + 16 + lane] = (bf16)f2bf(o2);
            }
        }
        {
            float v[6]; float ss = 0.f;
#pragma unroll
            for (int e = 0; e < 6; ++e) { v[e] = raw[256 + 6 * lane + e]; ss += v[e] * v[e]; }
            ss = wave_sum(ss); const float rinv = rsqrtf(ss * (1.0f / QL) + EPS);
#pragma unroll
            for (int e = 0; e < 6; ++e) CQN[(size_t)r * QL + 6 * lane + e] = (bf16)f2bf(v[e] * rinv * qa_norm[6 * lane + e]);
        }
        {
            const u32x4 w = *(const u32x4*)(Vb + (size_t)r * AW + 8 * lane); float v[8]; unpack8(w, v);
            float s = 0.f;
#pragma unroll
            for (int e = 0; e < 8; ++e) s += v[e];
            const float mean = wave_sum(s) * (1.0f / AW); float q = 0.f;
#pragma unroll
            for (int e = 0; e < 8; ++e) { v[e] -= mean; q += v[e] * v[e]; }
            const float rstd = rsqrtf(wave_sum(q) * (1.0f / AW) + EPS);
#pragma unroll
            for (int e = 0; e < 8; ++e) v[e] = v[e] * rstd * sgu_g[8 * lane + e] + sgu_b[8 * lane + e];
            u32x4 o; o.x = pk2(v[0], v[1]); o.y = pk2(v[2], v[3]); o.z = pk2(v[4], v[5]); o.w = pk2(v[6], v[7]);
            *(u32x4*)(VN + (size_t)r * AW + 8 * lane) = o;
            if (r >= TP) { float* o32 = out + O_VNS + (size_t)(r - TP) * AW + 8 * lane;
                *(f32x4*)o32 = (f32x4){v[0], v[1], v[2], v[3]}; *(f32x4*)(o32 + 4) = (f32x4){v[4], v[5], v[6], v[7]}; }
        }
    }
    GRID_BAR();

    for (int r = gw; r < T; r += ngw) {
        const int tc = (r < TP) ? (r & 127) : ((r - TP) & 7); const int start = r - tc; const int g = lane >> 4;
        float z[8];
#pragma unroll
        for (int e = 0; e < 8; ++e) z[e] = 0.f;
        const float* wrow = sgu_ws + ((size_t)g * 128 + tc) * 128;
        for (int s = 0; s <= tc; ++s) {
            const float w = wrow[s]; const u32x4 vw = *(const u32x4*)(VN + (size_t)(start + s) * AW + 8 * lane); float v[8]; unpack8(vw, v);
#pragma unroll
            for (int e = 0; e < 8; ++e) z[e] += w * v[e];
        }
        const float bsv = sgu_bs[g * 128 + tc];
        const u32x4 uw = *(const u32x4*)(Ub + (size_t)r * AW + 8 * lane); float u[8]; unpack8(uw, u);
#pragma unroll
        for (int e = 0; e < 8; ++e) z[e] = (z[e] + bsv) * u[e];
        u32x4 o; o.x = pk2(z[0], z[1]); o.y = pk2(z[2], z[3]); o.z = pk2(z[4], z[5]); o.w = pk2(z[6], z[7]);
        *(u32x4*)(UZ + (size_t)r * AW + 8 * lane) = o;
    }
    { ABf16 A{CQN, QL}; EpiBf E{QRAW, NH * QKH}; sgemm<false>(A, WUQT, T, NH * QKH, QL, E, gw, ngw, lane); }
    { ABf16 A{CKV, KVL}; EpiBf E{KVR, 1024}; sgemm<false>(A, WUKVT, T, 1024, KVL, E, gw, ngw, lane); }
    GRID_BAR();

    for (int r = gw; r < T; r += ngw) {
        const int h = lane >> 3, j = lane & 7; const int pos = tok_pos(r);
        {
            const bf16* qr = QRAW + (size_t)r * (NH * QKH) + h * QKH;
            float v[8]; unpack8(*(const u32x4*)(qr + 8 * j), v);
            const unsigned w1 = *(const unsigned*)(qr + 64 + 2 * j), w2 = *(const unsigned*)(qr + 80 + 2 * j);
            float x1[2] = {bflo(w1), bfhi(w1)}, x2[2] = {bflo(w2), bfhi(w2)}, o1[2], o2[2];
#pragma unroll
            for (int e = 0; e < 2; ++e) { float c, s; rope_cs(pos, 2 * j + e, c, s); o1[e] = x1[e] * c - x2[e] * s; o2[e] = x1[e] * s + x2[e] * c; }
            float ss = 0.f;
#pragma unroll
            for (int e = 0; e < 8; ++e) ss += v[e] * v[e];
            ss += (o1[0] * o1[0] + o1[1] * o1[1]) + (o2[0] * o2[0] + o2[1] * o2[1]);
            ss += __shfl_xor(ss, 1); ss += __shfl_xor(ss, 2); ss += __shfl_xor(ss, 4);
            const float rinv = rsqrtf(ss * (1.0f / QKH) + EPS);
            bf16* qo = Qn + (size_t)r * (NH * QKH) + h * QKH;
            u32x4 o; o.x = pk2(v[0] * rinv * q_norm[8 * j + 0], v[1] * rinv * q_norm[8 * j + 1]); o.y = pk2(v[2] * rinv * q_norm[8 * j + 2], v[3] * rinv * q_norm[8 * j + 3]);
            o.z = pk2(v[4] * rinv * q_norm[8 * j + 4], v[5] * rinv * q_norm[8 * j + 5]); o.w = pk2(v[6] * rinv * q_norm[8 * j + 6], v[7] * rinv * q_norm[8 * j + 7]);
            *(u32x4*)(qo + 8 * j) = o;
            *(unsigned*)(qo + 64 + 2 * j) = pk2(o1[0] * rinv * q_norm[64 + 2 * j], o1[1] * rinv * q_norm[65 + 2 * j]);
            *(unsigned*)(qo + 80 + 2 * j) = pk2(o2[0] * rinv * q_norm[80 + 2 * j], o2[1] * rinv * q_norm[81 + 2 * j]);
        }
        {
            const bf16* kr_ = KVR + (size_t)r * 1024 + h * 128;
            float v[8]; unpack8(*(const u32x4*)(kr_ + 8 * j), v);
            const u32x2 rw = *(const u32x2*)(KR + (size_t)r * ROPE + 4 * j);
            const float p0 = bflo(rw.x), p1 = bfhi(rw.x), p2 = bflo(rw.y), p3 = bfhi(rw.y);
            float ss = (p0 * p0 + p1 * p1) + (p2 * p2 + p3 * p3);
#pragma unroll
            for (int e = 0; e < 8; ++e) ss += v[e] * v[e];
            ss += __shfl_xor(ss, 1); ss += __shfl_xor(ss, 2); ss += __shfl_xor(ss, 4);
            const float rinv = rsqrtf(ss * (1.0f / QKH) + EPS);
            bf16* ko = KN + (size_t)r * (NH * QKH) + h * QKH;
            u32x4 o; o.x = pk2(v[0] * rinv * k_norm[8 * j + 0], v[1] * rinv * k_norm[8 * j + 1]); o.y = pk2(v[2] * rinv * k_norm[8 * j + 2], v[3] * rinv * k_norm[8 * j + 3]);
            o.z = pk2(v[4] * rinv * k_norm[8 * j + 4], v[5] * rinv * k_norm[8 * j + 5]); o.w = pk2(v[6] * rinv * k_norm[8 * j + 6], v[7] * rinv * k_norm[8 * j + 7]);
            *(u32x4*)(ko + 8 * j) = o;
            u32x2 po; po.x = pk2(p0 * rinv * k_norm[64 + 4 * j], p1 * rinv * k_norm[65 + 4 * j]); po.y = pk2(p2 * rinv * k_norm[66 + 4 * j], p3 * rinv * k_norm[67 + 4 * j]);
            *(u32x2*)(ko + 64 + 4 * j) = po;
        }
    }
    GRID_BAR();

    const float SCALE = 0.10206207261596575f;
    {
        const int ntask = 4 * NH * (SEQ / 64);
        for (int task = gw; task < ntask; task += ngw) {
            const int tb = (SEQ / 64 - 1) - (task / (4 * NH)), bh = task % (4 * NH), b = bh >> 3, h = bh & 7;
            const int t = tb * 64 + lane; const size_t r = (size_t)b * SEQ + t;
            float q[QKH];
#pragma unroll
            for (int c = 0; c < 12; ++c) unpack8(*(const u32x4*)(Qn + r * (NH * QKH) + h * QKH + 8 * c), q + 8 * c);
            float o[VD];
#pragma unroll
            for (int d = 0; d < VD; ++d) o[d] = 0.f;
            float m = -1e30f, l = 0.f;
            const int smax = tb * 64 + 63;
            for (int s = 0; s <= smax; ++s) {
                const size_t rs = (size_t)b * SEQ + s;
                const bf16* kp = KN + rs * (NH * QKH) + h * QKH;
                float sc = 0.f;
#pragma unroll
                for (int c = 0; c < 12; ++c) { float kv[8]; unpack8(*(const u32x4*)(kp + 8 * c), kv);
#pragma unroll
                    for (int e = 0; e < 8; ++e) sc += q[8 * c + e] * kv[e]; }
                sc *= SCALE;
                const bool ok = (s <= t);
                const float mn = ok ? fmaxf(m, sc) : m;
                const float alpha = __expf(m - mn), p = ok ? __expf(sc - mn) : 0.f;
                m = mn; l = l * alpha + p;
                const bf16* vp = KVR + rs * 1024 + h * 128 + 64;
#pragma unroll
                for (int c = 0; c < 8; ++c) { float vv[8]; unpack8(*(const u32x4*)(vp + 8 * c), vv);
#pragma unroll
                    for (int e = 0; e < 8; ++e) o[8 * c + e] = o[8 * c + e] * alpha + p * vv[e]; }
            }
            const float il = 1.0f / l;
            bf16* op = Ob + r * AW + h * VD;
#pragma unroll
            for (int c = 0; c < 8; ++c) { u32x4 w; w.x = pk2(o[8 * c] * il, o[8 * c + 1] * il); w.y = pk2(o[8 * c + 2] * il, o[8 * c + 3] * il); w.z = pk2(o[8 * c + 4] * il, o[8 * c + 5] * il); w.w = pk2(o[8 * c + 6] * il, o[8 * c + 7] * il);
                *(u32x4*)(op + 8 * c) = w; }
        }
    }
    {
        for (int seq = gw; seq < DECB; seq += ngw) {
            const int h = lane >> 3, t = lane & 7; const size_t r = (size_t)TP + seq * DECS + t;
            float qg[QKH];
#pragma unroll
            for (int c = 0; c < 12; ++c) unpack8(*(const u32x4*)(Qn + r * (NH * QKH) + h * QKH + 8 * c), qg + 8 * c);
#pragma unroll
            for (int d = 0; d < QKH; ++d) qg[d] *= k_norm[d];
            float o[VD];
#pragma unroll
            for (int d = 0; d < VD; ++d) o[d] = 0.f;
            float m = -1e30f, l = 0.f;
            for (int j = 0; j < PAST + DECS; ++j) {
                const bf16* kp; float kr[ROPE];
                if (j < PAST) {
                    const int page = pt[seq * NPAGES + (j >> 7)]; const size_t crow = (size_t)page * PAGE + (j & 127);
                    kp = KPAST + ((size_t)seq * PAST + j) * 1024 + h * 128;
                    const float* krp = cache_kr + crow * ROPE;
#pragma unroll
                    for (int c = 0; c < 8; ++c) { const f32x4 kv = *(const f32x4*)(krp + 4 * c); kr[4 * c] = kv[0]; kr[4 * c + 1] = kv[1]; kr[4 * c + 2] = kv[2]; kr[4 * c + 3] = kv[3]; }
                } else {
                    const size_t rs = (size_t)TP + seq * DECS + (j - PAST);
                    kp = KVR + rs * 1024 + h * 128;
#pragma unroll
                    for (int c = 0; c < 4; ++c) unpack8(*(const u32x4*)(KR + rs * ROPE + 8 * c), kr + 8 * c);
                }
                float dot = 0.f, ss = 0.f;
#pragma unroll
                for (int c = 0; c < 8; ++c) { float kv[8]; unpack8(*(const u32x4*)(kp + 8 * c), kv);
#pragma unroll
                    for (int e = 0; e < 8; ++e) { dot += qg[8 * c + e] * kv[e]; ss += kv[e] * kv[e]; } }
#pragma unroll
                for (int e = 0; e < ROPE; ++e) { dot += qg[64 + e] * kr[e]; ss += kr[e] * kr[e]; }
                const float sc = dot * rsqrtf(ss * (1.0f / QKH) + EPS) * SCALE;
                const bool ok = (j - PAST <= t);
                const float mn = ok ? fmaxf(m, sc) : m;
                const float alpha = __expf(m - mn), p = ok ? __expf(sc - mn) : 0.f;
                m = mn; l = l * alpha + p;
#pragma unroll
                for (int c = 0; c < 8; ++c) { float vv[8]; unpack8(*(const u32x4*)(kp + 64 + 8 * c), vv);
#pragma unroll
                    for (int e = 0; e < 8; ++e) o[8 * c + e] = o[8 * c + e] * alpha + p * vv[e]; }
            }
            const float il = 1.0f / l;
            bf16* op = Ob + r * AW + h * VD;
#pragma unroll
            for (int c = 0; c < 8; ++c) { u32x4 w; w.x = pk2(o[8 * c] * il, o[8 * c + 1] * il); w.y = pk2(o[8 * c + 2] * il, o[8 * c + 3] * il); w.z = pk2(o[8 * c + 4] * il, o[8 * c + 5] * il); w.w = pk2(o[8 * c + 6] * il, o[8 * c + 7] * il);
                *(u32x4*)(op + 8 * c) = w; }
        }
    }
    GRID_BAR();

    { ABf16 A{UZ, AW}; EpiGateA E{MXF, SG}; sgemm<false>(A, WAT, T, DM, AW, E, gw, ngw, lane); }
    GRID_BAR();
    { ABf16 A{Ob, AW}; EpiGateB E{MXF, SG, MX}; sgemm<false>(A, WBT, T, DM, AW, E, gw, ngw, lane); }
    GRID_BAR();
    { ABf16 A{MX, DM}; EpiResid E{Y, Y + (size_t)TP * DM, Y, HB, SSH2, 1.0f}; sgemm<false>(A, WOT, T, DM, DM, E, gw, ngw, lane); }
    GRID_BAR();
    { ABf16 A{HB, DM}; EpiSwiglu E{ACT, SSH2}; sgemm<true>(A, W3T, T, NFF, DM, E, gw, ngw, lane); }
    GRID_BAR();
    { ABf16 A{ACT, DFF}; EpiResid E{Y, Y + (size_t)TP * DM, Y, HB, SSH3, 0.5f}; sgemm<false>(A, W4T, T, DM, DFF, E, gw, ngw, lane); }
    GRID_BAR();
    { ABf16 A{HB, DM}; EpiPle E{Y, PP, SSH3}; sgemm<false>(A, WGT, T, DM, DM, E, gw, ngw, lane); }
}

extern "C" void kernel_launch(void* const* d_in, const int* in_sizes, int n_in, void* d_out, int out_size, void* d_ws, size_t ws_size, hipStream_t stream) {
    static int grid = 0;
    if (grid == 0) {
        if (n_in != 31 || (size_t)out_size != O_END || ws_size < WS_END) { fprintf(stderr, "kernel_launch: unexpected shapes: n_in %d out %d ws %zu\n", n_in, out_size, ws_size); grid = -1; return; }
        int dev = 0, cus = 0, per_cu = 0;
        if (hipGetDevice(&dev) != hipSuccess || hipDeviceGetAttribute(&cus, hipDeviceAttributeMultiprocessorCount, dev) != hipSuccess) { grid = -1; return; }
        if (hipFuncSetAttribute((const void*)fwd, hipFuncAttributeMaxDynamicSharedMemorySize, LDS_BYTES) != hipSuccess) { fprintf(stderr, "kernel_launch: hipFuncSetAttribute failed\n"); grid = -1; return; }
        if (hipOccupancyMaxActiveBlocksPerMultiprocessor(&per_cu, (const void*)fwd, NTHREADS, LDS_BYTES) != hipSuccess || per_cu < 1) { fprintf(stderr, "kernel_launch: occupancy query says %d\n", per_cu); grid = -1; (void)hipGetLastError(); return; }
        grid = cus;
    }
    if (grid < 0) return;
    (void)hipMemsetAsync((char*)d_ws + WS_CTL, 0, CTL_ZERO_BYTES, stream);
    Args a{};
    for (int i = 0; i < 31; ++i) a.in[i] = (const float*)d_in[i];
    a.pt = (const int*)d_in[4]; a.out = (float*)d_out; a.ws = (unsigned char*)d_ws;
    hipLaunchKernelGGL(fwd, dim3(grid), dim3(NTHREADS), LDS_BYTES, stream, a);
}
```

```cpp
#include <hip/hip_runtime.h>
#include <cstdio>
#include <cstdint>

#define GAS __attribute__((address_space(1)))
#define LAS __attribute__((address_space(3)))
typedef unsigned short bf16;
typedef short bf16x8 __attribute__((ext_vector_type(8)));
typedef float f32x4 __attribute__((ext_vector_type(4)));
typedef unsigned u32x4 __attribute__((ext_vector_type(4)));
typedef unsigned u32x2 __attribute__((ext_vector_type(2)));

constexpr int DM = 1024, TP = 16384, TS = 1024, T = TP + TS, SEQ = 4096, DFF = 2816, NFF = 2 * DFF;
constexpr int AW = 512, QL = 384, KVL = 256, ROPE = 32, NH = 8, QKH = 96, NOPE = 64, VD = 64, PLE = 256;
constexpr int INC = 3744, INP = 3840;
constexpr int PAST = 8192, PAGE = 128, NPAGES = 64, DECB = 128, DECS = 8;
constexpr float EPS = 1e-6f;
constexpr int NWAVES = 8, NTHREADS = 512;

constexpr size_t O_Y = 0, O_CKVP = (size_t)T * DM, O_KRP = O_CKVP + (size_t)TP * KVL, O_CKVS = O_KRP + (size_t)TP * ROPE,
                 O_KRS = O_CKVS + (size_t)TS * KVL, O_VNS = O_KRS + (size_t)TS * ROPE, O_END = O_VNS + (size_t)TS * AW;

constexpr size_t MiB = 1u << 20;
constexpr size_t WS_CTL = 0, CTL_ZERO_BYTES = 1 * MiB;
constexpr size_t CTL_BAR_WORD = 4096;
constexpr size_t CTL_SSH1 = 262144, CTL_SSH2 = CTL_SSH1 + 131072, CTL_SSH3 = CTL_SSH2 + 131072;
constexpr size_t WS_W1T = 2 * MiB, WS_W2T = 14 * MiB, WS_WINT = 20 * MiB, WS_WUQT = 28 * MiB, WS_WUKVT = 29 * MiB, WS_WAT = 30 * MiB,
                 WS_WBT = 31 * MiB, WS_WOT = 32 * MiB, WS_W3T = 34 * MiB, WS_W4T = 46 * MiB, WS_WGT = 52 * MiB, WS_WPT = 54 * MiB, WS_WSB = 55 * MiB, WS_ROPE = 56 * MiB, WS_GQK = 57 * MiB;
constexpr size_t WS_XB = 64 * MiB, WS_HB = 100 * MiB, WS_ACT = 136 * MiB, WS_U = 232 * MiB, WS_V = 250 * MiB, WS_VN = 268 * MiB,
                 WS_RAW = 286 * MiB, WS_SG = 338 * MiB, WS_CKV = 408 * MiB, WS_KR = 418 * MiB, WS_CQN = 420 * MiB, WS_UZ = 434 * MiB,
                 WS_QRAW = 452 * MiB, WS_Q = 478 * MiB, WS_KVR = 504 * MiB, WS_KN = 538 * MiB, WS_O = 564 * MiB, WS_MXF = 582 * MiB,
                 WS_MX = 650 * MiB, WS_PP = 684 * MiB, WS_PB = 752 * MiB, WS_SSX = 762 * MiB, WS_KPAST = 1024 * MiB, WS_END = 3072 * MiB;

constexpr int LDS_BYTES = 163840, MISC_OFF = 155648;

__device__ __forceinline__ unsigned f2bf(float f) { unsigned u = __builtin_bit_cast(unsigned, f); return (u + 0x7fffu + ((u >> 16) & 1u)) >> 16; }
typedef __bf16 bf16x2_t __attribute__((ext_vector_type(2)));
typedef float f32x2_t __attribute__((ext_vector_type(2)));
__device__ __forceinline__ unsigned cvtpk(float lo, float hi) { f32x2_t v = {lo, hi}; bf16x2_t b = __builtin_convertvector(v, bf16x2_t); return __builtin_bit_cast(unsigned, b); }
__device__ __forceinline__ unsigned pk2(float lo, float hi) { return cvtpk(lo, hi); }
__device__ __forceinline__ float bf2f(unsigned b) { return __builtin_bit_cast(float, b << 16); }
__device__ __forceinline__ float bflo(unsigned w) { return __builtin_bit_cast(float, w << 16); }
__device__ __forceinline__ float bfhi(unsigned w) { return __builtin_bit_cast(float, w & 0xffff0000u); }
template <int CTRL> __device__ __forceinline__ float dpp_f(float v) { return __builtin_bit_cast(float, __builtin_amdgcn_update_dpp(0, __builtin_bit_cast(int, v), CTRL, 0xF, 0xF, true)); }
__device__ __forceinline__ float sum8(float v) {
    v += dpp_f<0xB1>(v);
    v += dpp_f<0x4E>(v);
    v += dpp_f<0x141>(v);
    return v;
}
__device__ __forceinline__ float sum16(float v) { v = sum8(v); v += dpp_f<0x140>(v); return v; }
__device__ __forceinline__ float xor32_sum(float v) { float a = v, b = v; asm volatile("s_nop 1\n\tv_permlane32_swap_b32 %0, %1\n\ts_nop 1" : "+v"(a), "+v"(b)); return a + b; }
__device__ __forceinline__ float wave_sum(float v) {
    v = sum16(v);
    v += __shfl_xor(v, 16);
    return xor32_sum(v);
}
__device__ __forceinline__ float sigmoidf_(float x) { return __builtin_amdgcn_rcpf(1.0f + __builtin_amdgcn_exp2f(-1.4426950408889634f * x)); }
__device__ __forceinline__ float gelu_tanh(float x) {
    const float y = 0.7978845608028654f * (x + 0.044715f * x * x * x);
    const float e = __builtin_amdgcn_exp2f(2.8853900817779268f * y);
    const float th = 1.0f - 2.0f * __builtin_amdgcn_rcpf(e + 1.0f);
    return 0.5f * x * (1.0f + th);
}
__device__ __forceinline__ void unpack8(const u32x4 w, float* f) {
    f[0] = bflo(w.x); f[1] = bfhi(w.x); f[2] = bflo(w.y); f[3] = bfhi(w.y); f[4] = bflo(w.z); f[5] = bfhi(w.z); f[6] = bflo(w.w); f[7] = bfhi(w.w);
}

#define XB_TMO      128
#define XB_XCNT(j)  (256  + 64 * (j))
#define XB_XSUB(j)  (1280 + 64 * (j))
#define XB_XGEN(j)  (2304 + 64 * (j))
#define XB_TOP      3328
#define XB_TOPGEN   3392
#define XCD_BAR_WORDS 3456
#define XB_SPIN_CAP (1u << 21)
__device__ __forceinline__ unsigned xb_ld(unsigned* p)              { return __hip_atomic_load(p, __ATOMIC_RELAXED, __HIP_MEMORY_SCOPE_AGENT); }
__device__ __forceinline__ unsigned xb_add(unsigned* p, unsigned v) { return __hip_atomic_fetch_add(p, v, __ATOMIC_RELAXED, __HIP_MEMORY_SCOPE_AGENT); }
__device__ __forceinline__ unsigned xb_xcc_id() { return (unsigned)__builtin_amdgcn_s_getreg((3 << 11) | 20) & 0xFu; }
#define XB_SPIN(cond, bar) do { unsigned _sp = 0; while (cond) { __builtin_amdgcn_s_sleep(1); \
    if ((++_sp & 255u) == 0u) { if (xb_ld(&(bar)[XB_TMO])) break; if (_sp > XB_SPIN_CAP) { atomicAdd(&(bar)[XB_TMO], 1u); break; } } } } while (0)
struct XcdBarrier { unsigned* bar; unsigned x; volatile LAS unsigned* st; };
__device__ __forceinline__ XcdBarrier xcd_barrier_post(unsigned* bar, volatile LAS unsigned* st) {
    XcdBarrier b; b.bar = bar; b.x = xb_xcc_id(); b.st = st;
    if (threadIdx.x == 0) (void)xb_add(&bar[XB_XCNT(b.x)], 1u);
    return b;
}
__device__ __forceinline__ void xcd_barrier_complete(unsigned* bar, unsigned x, unsigned& nloc, unsigned& nx) {
    const unsigned G = gridDim.x * gridDim.y * gridDim.z;
    unsigned sum, cnt, mine, sp = 0u;
    for (;;) {
        sum = 0u; cnt = 0u; mine = 0u;
#pragma unroll
        for (unsigned j = 0; j < 16; ++j) { const unsigned c = xb_ld(&bar[XB_XCNT(j)]); sum += c; cnt += (c > 0u) ? 1u : 0u; mine = (j == x) ? c : mine; }
        if (sum == G) break;
        __builtin_amdgcn_s_sleep(1);
        if ((++sp & 255u) == 0u) { if (xb_ld(&bar[XB_TMO])) break; if (sp > XB_SPIN_CAP) { atomicAdd(&bar[XB_TMO], 1u); break; } }
    }
    nloc = mine > 0u ? mine : 1u; nx = cnt > 0u ? cnt : 1u;
}
__device__ __forceinline__ void xcd_barrier(const XcdBarrier& b) {
    asm volatile("s_waitcnt vmcnt(0)" ::: "memory");
    __syncthreads();
    if (threadIdx.x == 0) {
        unsigned* bar = b.bar;
        __builtin_amdgcn_s_waitcnt(0);
        unsigned nloc = b.st[0], nx = b.st[1];
        if (nloc == 0u) { xcd_barrier_complete(bar, b.x, nloc, nx); b.st[0] = nloc; b.st[1] = nx; }
        const unsigned old = xb_add(&bar[XB_XSUB(b.x)], 1u);
        const unsigned gen = old / nloc;
        if (old + 1u == (gen + 1u) * nloc) {
            __builtin_amdgcn_fence(__ATOMIC_RELEASE, "agent");
            asm volatile("s_waitcnt vmcnt(0)" ::: "memory");
            const unsigned og = xb_add(&bar[XB_TOP], 1u);
            const unsigned tg = og / nx;
            if (og + 1u == (tg + 1u) * nx) xb_add(&bar[XB_TOPGEN], 1u);
            else XB_SPIN(xb_ld(&bar[XB_TOPGEN]) == tg, bar);
            __builtin_amdgcn_fence(__ATOMIC_ACQUIRE, "agent");
            xb_add(&bar[XB_XGEN(b.x)], 1u);
            asm volatile("s_waitcnt vmcnt(0)" ::: "memory");
        } else {
            XB_SPIN(xb_ld(&bar[XB_XGEN(b.x)]) == gen, bar);
            __builtin_amdgcn_fence(__ATOMIC_ACQUIRE, "agent");
            asm volatile("s_waitcnt vmcnt(0)" ::: "memory");
        }
    }
    __syncthreads();
}

struct Args {
    const float* in[31]; const int* pt; float* out; unsigned char* ws;
};

__device__ __forceinline__ void st_bf4(bf16* p, float a, float b, float c, float d) { u32x2 w; w.x = pk2(a, b); w.y = pk2(c, d); *(u32x2*)p = w; }

constexpr int SSL_OFF = 131072;
__device__ __forceinline__ float ssl_rinv(const LAS unsigned char* lds, int row, int buf) { return __builtin_amdgcn_rsqf(*(const LAS float*)(lds + SSL_OFF + (buf << 10) + ((row & 255) << 2)) * (1.0f / DM) + EPS); }
struct EpiSwiglu {
    static constexpr bool NEED_SS = false;
    bf16* ACT; const LAS unsigned char* lds;
    __device__ __forceinline__ float rowinit(int row, int buf) const { return ssl_rinv(lds, row, buf); }
    __device__ __forceinline__ void pair(int row, int pcol, const f32x4& a, const f32x4& b, float rinv) const {
        const float r2 = -1.4426950408889634f * rinv, rr = rinv * rinv;
        const f32x4 t = a * r2; f32x4 e;
#pragma unroll
        for (int i = 0; i < 4; ++i) e[i] = __builtin_amdgcn_exp2f(t[i]);
        const f32x4 d = e + 1.0f; f32x4 sg;
#pragma unroll
        for (int i = 0; i < 4; ++i) sg[i] = __builtin_amdgcn_rcpf(d[i]);
        const f32x4 o = (a * b) * rr * sg;
        st_bf4(ACT + (size_t)row * DFF + pcol, o[0], o[1], o[2], o[3]);
    }
    __device__ __forceinline__ float quad(int, int, const f32x4&, float) const { return 0.f; }
    __device__ __forceinline__ void rowsum(int, float) const {}
};
struct EpiResid {
    static constexpr bool NEED_SS = true;
    __device__ __forceinline__ float rowinit(int row, int buf) const { (void)row; (void)buf; return 0.f; }
    const bf16* base; bf16* HB; float* ssout; float scale;
    __device__ __forceinline__ float quad(int row, int col, const f32x4& v, float rinv) const {
        const u32x2 b = *(const u32x2*)(base + (size_t)row * DM + col);
        const float h0 = bflo(b.x) + v[0] * scale, h1 = bfhi(b.x) + v[1] * scale, h2 = bflo(b.y) + v[2] * scale, h3 = bfhi(b.y) + v[3] * scale;
        st_bf4(HB + (size_t)row * DM + col, h0, h1, h2, h3);
        return (h0 * h0 + h1 * h1) + (h2 * h2 + h3 * h3);
    }
    __device__ __forceinline__ void rowsum(int row, float s) const { atomicAdd(ssout + row, s); }
    __device__ __forceinline__ void pair(int, int, const f32x4&, const f32x4&, float) const {}
};
struct EpiIn {
    static constexpr bool NEED_SS = false; static constexpr int REGIONS = 4;
    __device__ __forceinline__ float rowinit(int row, int buf) const { return ssl_rinv(lds, row, buf); }
    bf16* U; bf16* V; float* RAW; bf16* SG; const LAS unsigned char* lds;
    __device__ __forceinline__ int region(int pn) const { return pn < 2 ? 0 : pn < 4 ? 1 : pn < 7 ? 2 : 3; }
    template <int R> __device__ __forceinline__ float quadr(int row, int col, const f32x4& v, float rinv) const {
        const f32x4 x = v * rinv;
        if (R == 0) st_bf4(U + (size_t)row * AW + col, gelu_tanh(x[0]), gelu_tanh(x[1]), gelu_tanh(x[2]), gelu_tanh(x[3]));
        else if (R == 1) st_bf4(V + (size_t)row * AW + (col - 512), gelu_tanh(x[0]), gelu_tanh(x[1]), gelu_tanh(x[2]), gelu_tanh(x[3]));
        else if (R == 2) *(f32x4*)(RAW + (size_t)row * 768 + (col - 1024)) = x;
        else st_bf4(SG + (size_t)row * 2048 + (col - 1792), sigmoidf_(x[0]), sigmoidf_(x[1]), sigmoidf_(x[2]), sigmoidf_(x[3]));
        return 0.f;
    }
    __device__ __forceinline__ float quad(int row, int col, const f32x4& v, float rinv) const { return quadr<3>(row, col, v, rinv); }
    __device__ __forceinline__ void rowsum(int, float) const {}
    __device__ __forceinline__ void pair(int, int, const f32x4&, const f32x4&, float) const {}
};
struct EpiBf {
    static constexpr bool NEED_SS = false;
    __device__ __forceinline__ float rowinit(int row, int buf) const { (void)row; (void)buf; return 0.f; }
    bf16* O; int ldc;
    __device__ __forceinline__ float quad(int row, int col, const f32x4& v, float rinv) const { st_bf4(O + (size_t)row * ldc + col, v[0], v[1], v[2], v[3]); return 0.f; }
    __device__ __forceinline__ void rowsum(int, float) const {}
    __device__ __forceinline__ void pair(int, int, const f32x4&, const f32x4&, float) const {}
};
struct EpiF32 {
    static constexpr bool NEED_SS = false;
    __device__ __forceinline__ float rowinit(int row, int buf) const { (void)row; (void)buf; return 0.f; }
    float* O; int ldc;
    __device__ __forceinline__ float quad(int row, int col, const f32x4& v, float rinv) const { *(f32x4*)(O + (size_t)row * ldc + col) = v; return 0.f; }
    __device__ __forceinline__ void rowsum(int, float) const {}
    __device__ __forceinline__ void pair(int, int, const f32x4&, const f32x4&, float) const {}
};
struct EpiGateA {
    static constexpr bool NEED_SS = false;
    __device__ __forceinline__ float rowinit(int row, int buf) const { (void)row; (void)buf; return 0.f; }
    bf16* MXF; const bf16* SG;
    __device__ __forceinline__ float quad(int row, int col, const f32x4& v, float rinv) const {
        const u32x2 g = *(const u32x2*)(SG + (size_t)row * 2048 + col);
        st_bf4(MXF + (size_t)row * DM + col, bflo(g.x) * v[0], bfhi(g.x) * v[1], bflo(g.y) * v[2], bfhi(g.y) * v[3]); return 0.f;
    }
    __device__ __forceinline__ void rowsum(int, float) const {}
    __device__ __forceinline__ void pair(int, int, const f32x4&, const f32x4&, float) const {}
};
struct EpiGateB {
    static constexpr bool NEED_SS = false;
    __device__ __forceinline__ float rowinit(int row, int buf) const { (void)row; (void)buf; return 0.f; }
    const bf16* MXF; const bf16* SG; bf16* MX;
    __device__ __forceinline__ float quad(int row, int col, const f32x4& v, float rinv) const {
        const u32x2 g = *(const u32x2*)(SG + (size_t)row * 2048 + 1024 + col);
        const u32x2 m = *(const u32x2*)(MXF + (size_t)row * DM + col);
        st_bf4(MX + (size_t)row * DM + col, bflo(m.x) + bflo(g.x) * v[0], bfhi(m.x) + bfhi(g.x) * v[1], bflo(m.y) + bflo(g.y) * v[2], bfhi(m.y) + bfhi(g.y) * v[3]);
        return 0.f;
    }
    __device__ __forceinline__ void rowsum(int, float) const {}
    __device__ __forceinline__ void pair(int, int, const f32x4&, const f32x4&, float) const {}
};
template <bool SSL> struct EpiPleT {
    static constexpr bool NEED_SS = false;
    __device__ __forceinline__ float rowinit(int row, int buf) const { if constexpr (SSL) return ssl_rinv(lds, row, buf); else return rsqrtf(ss[row] * (1.0f / DM) + EPS); }
    float* Y; const bf16* HB; const bf16* PP; const float* ss; const LAS unsigned char* lds;
    __device__ __forceinline__ float quad(int row, int col, const f32x4& v, float rinv) const {
        const u32x2 hw = *(const u32x2*)(HB + (size_t)row * DM + col); const u32x2 pw = *(const u32x2*)(PP + (size_t)row * DM + col);
        const float h[4] = {bflo(hw.x), bfhi(hw.x), bflo(hw.y), bfhi(hw.y)}; const float p[4] = {bflo(pw.x), bfhi(pw.x), bflo(pw.y), bfhi(pw.y)};
        f32x4 o;
#pragma unroll
        for (int e = 0; e < 4; ++e) o[e] = h[e] + sigmoidf_(v[e] * rinv) * p[e];
        *(f32x4*)(Y + (size_t)row * DM + col) = o; return 0.f;
    }
    __device__ __forceinline__ void rowsum(int, float) const {}
    __device__ __forceinline__ void pair(int, int, const f32x4&, const f32x4&, float) const {}
};

namespace pg8 {
#define PG8_LAS __attribute__((address_space(3)))
typedef unsigned short bf16_t;
typedef short bf16x8 __attribute__((ext_vector_type(8)));
typedef float f32x4 __attribute__((ext_vector_type(4)));
typedef unsigned u32x4 __attribute__((ext_vector_type(4)));
constexpr int BM = 256, BK = 64, HALF = 128, HTB = HALF * BK * 2  , STAGE_BYTES = 8 * HTB, NXCD = 8, WGM = 8;

__host__ __device__ __forceinline__ int lds_byte(int r, int c) { const int st = (r >> 4) * 2 + (c >> 5), rr = r & 15, cc = c & 31, ob = rr * 64 + cc * 2; return st * 1024 + (ob ^ (((ob >> 9) & 1) << 5)); }
__host__ __device__ __forceinline__ void stage_rc(int b, int& R, int& C) { const int st = b / 1024, sb = b % 1024, swz = sb ^ (((sb >> 9) & 1) << 5); R = (st >> 1) * 16 + swz / 64; C = (st & 1) * 32 + (swz % 64) / 2; }
__host__ __device__ __forceinline__ int perm32(int rho) { const int n = rho >> 4, i = rho & 15; return 8 * (i >> 2) + 4 * n + (i & 3); }

struct Unit { int pm, pn; };
struct Gemm { const bf16_t* A; const bf16_t* Bt; int M, N, K; };

struct StaticOrder {
    int nM, nN, nwg, G, c;
    __host__ __device__ void init(int M, int N, int G_, int c_) { nM = M / BM; nN = N / BM; nwg = nM * nN; G = G_; c = c_; }
    __host__ __device__ bool next(int i, Unit& u) const {
        const long L = (long)i * G + c; if (L >= nwg) return false;
        int wgid = (int)L; { const int q = nwg / NXCD, r = nwg % NXCD, xcd = wgid % NXCD, off = wgid / NXCD; wgid = (xcd < r ? xcd * (q + 1) : r * (q + 1) + (xcd - r) * q) + off; }
        const int nig = WGM * nN, gid = wgid / nig, fm = gid * WGM, gsz = (nM - fm) < WGM ? (nM - fm) : WGM;
        u.pm = fm + ((wgid % nig) % gsz); u.pn = (wgid % nig) / gsz; return true;
    }
    __device__ __forceinline__ void a_ready(const Unit&) const {}
    __device__ __forceinline__ void done(const Unit&) const {}
};


template <class Epi, class Sched, bool ALIGN_EPI = false, bool SP2 = false>
__device__ __forceinline__ void gemm_phase(PG8_LAS unsigned char* lds, const Gemm g, const Sched& S, const Epi& E) {
    int tid_l = threadIdx.x; asm volatile("" : "+v"(tid_l));
    const int tid = tid_l, wid = __builtin_amdgcn_readfirstlane(tid >> 6), lane = tid & 63, wr = wid >> 2, wc = wid & 3, fr = lane & 15, fq = lane >> 4;
    const int K = g.K, nt = K / BK;
    unsigned voffA[2], voffB[2];
#pragma unroll
    for (int i = 0; i < 2; ++i) { int R, C; stage_rc(tid * 16 + i * 8192, R, C); const int Rb = Epi::PERM ? ((R & ~31) + perm32(R & 31)) : R;
        voffA[i] = (unsigned)(R * K + C) * 2u; voffB[i] = (unsigned)(Rb * K + C) * 2u; }
    const size_t kstep = (size_t)(BK * 2);
    const size_t hstep = (size_t)HALF * K * 2;
    const size_t tstep = 2 * hstep;
    const unsigned ldsw = (unsigned)wid * 1024u;
    const int aoff = lds_byte(wr * 64 + fr, fq * 8), boff = lds_byte(wc * 32 + fr, fq * 8);
#define PG8_SA(b, h) (((b) * 2 + (h)) * HTB)
#define PG8_SB(b, h) ((4 + (b) * 2 + (h)) * HTB)
#define PG8_STAGE(bufoff, gbase, voff) do { _Pragma("unroll") for (int _i = 0; _i < 2; ++_i) \
        __builtin_amdgcn_global_load_lds((const unsigned*)((const char*)(gbase) + (voff)[_i]), (PG8_LAS unsigned*)(lds + (bufoff) + ldsw + _i * 8192), 16, 0, 0); } while (0)
#define PG8_LDA(dst, b, h) do { _Pragma("unroll") for (int m = 0; m < 4; ++m) _Pragma("unroll") for (int k = 0; k < 2; ++k) dst[m][k] = *(const PG8_LAS bf16x8*)(lds + PG8_SA(b, h) + aoff + m * 2048 + k * 1024); } while (0)
#define PG8_LDB(dst, b, h) do { _Pragma("unroll") for (int n = 0; n < 2; ++n) _Pragma("unroll") for (int k = 0; k < 2; ++k) dst[n][k] = *(const PG8_LAS bf16x8*)(lds + PG8_SB(b, h) + boff + n * 2048 + k * 1024); } while (0)
#define PG8_MMA(ai, bj, At, Bt) do { __builtin_amdgcn_s_setprio(1); _Pragma("unroll") for (int m = 0; m < 4; ++m) _Pragma("unroll") for (int n = 0; n < 2; ++n) _Pragma("unroll") for (int k = 0; k < 2; ++k) \
        acc[ai][bj][m][n] = __builtin_amdgcn_mfma_f32_16x16x32_bf16(Bt[n][k], At[m][k], acc[ai][bj][m][n], 0, 0, 0); __builtin_amdgcn_s_setprio(0); } while (0)
#define PG8_WAIT_V(n) asm volatile("s_waitcnt vmcnt(" #n ")" ::: "memory")
#define PG8_WAIT_L(n) asm volatile("s_waitcnt lgkmcnt(" #n ")" ::: "memory")
#define PG8_BAR __builtin_amdgcn_s_barrier()
#define PG8_SCHED __builtin_amdgcn_sched_barrier(0)
    Unit cur, nxt; int ui = 0;
    if (!S.next(0, cur)) return;
    f32x4 acc[2][2][4][2];
#pragma unroll
    for (int a = 0; a < 2; ++a)
#pragma unroll
        for (int b = 0; b < 2; ++b)
#pragma unroll
            for (int m = 0; m < 4; ++m)
#pragma unroll
                for (int n = 0; n < 2; ++n) acc[a][b][m][n] = (f32x4){0.f, 0.f, 0.f, 0.f};
    bf16x8 At[4][2], B0[2][2], B1[2][2];
    const char* cA = (const char*)g.A + (size_t)cur.pm * tstep; const char* cB = (const char*)g.Bt + (size_t)cur.pn * tstep;
    S.a_ready(cur);
    if constexpr (SP2) {
        PG8_STAGE(PG8_SB(0, 0), cB, voffB); PG8_STAGE(PG8_SB(0, 1), cB + hstep, voffB); PG8_STAGE(PG8_SA(0, 0), cA, voffA); PG8_STAGE(PG8_SA(0, 1), cA + hstep, voffA);
        if (wr == 1) PG8_BAR;
        PG8_WAIT_V(2); PG8_BAR;
        PG8_STAGE(PG8_SB(1, 0), cB + kstep, voffB); PG8_STAGE(PG8_SA(1, 0), cA + kstep, voffA); PG8_STAGE(PG8_SB(1, 1), cB + hstep + kstep, voffB);
        PG8_WAIT_V(6); PG8_BAR;
    } else {
        PG8_STAGE(PG8_SB(0, 0), cB, voffB); PG8_STAGE(PG8_SA(0, 0), cA, voffA); PG8_STAGE(PG8_SB(0, 1), cB + hstep, voffB); PG8_STAGE(PG8_SA(0, 1), cA + hstep, voffA);
        if (wr == 1) PG8_BAR;
        PG8_WAIT_V(4); PG8_BAR;
        PG8_STAGE(PG8_SB(1, 0), cB + kstep, voffB); PG8_STAGE(PG8_SA(1, 0), cA + kstep, voffA); PG8_STAGE(PG8_SB(1, 1), cB + hstep + kstep, voffB);
        PG8_WAIT_V(6); PG8_BAR;
    }
    for (;;) {
        const bool has_next = S.next(ui + 1, nxt);
        const char* nA = has_next ? (const char*)g.A + (size_t)nxt.pm * tstep : cA; const char* nB = has_next ? (const char*)g.Bt + (size_t)nxt.pn * tstep : cB;
        for (int t = 0; t < nt; t += 2) {
            const bool last = (t == nt - 2);
            const char* a1 = cA + (size_t)(t + 1) * kstep;
            const char* a2 = last ? nA : cA + (size_t)(t + 2) * kstep; const char* b2 = last ? nB : cB + (size_t)(t + 2) * kstep;
            const char* a3 = a2 + kstep; const char* b3 = b2 + kstep;
            if (last && has_next) S.a_ready(nxt);
            if constexpr (SP2) {
            PG8_LDB(B0, 0, 0); PG8_LDB(B1, 0, 1); PG8_SCHED; PG8_LDA(At, 0, 0); PG8_STAGE(PG8_SA(1, 1), a1 + hstep, voffA);
            PG8_WAIT_V(8); PG8_WAIT_L(0); PG8_BAR; PG8_MMA(0, 0, At, B0); PG8_MMA(0, 1, At, B1); PG8_BAR; PG8_SCHED;
            PG8_LDA(At, 0, 1); PG8_STAGE(PG8_SB(0, 0), b2, voffB); PG8_STAGE(PG8_SB(0, 1), b2 + hstep, voffB); PG8_STAGE(PG8_SA(0, 0), a2, voffA);
            PG8_WAIT_V(8); PG8_WAIT_L(0); PG8_BAR; PG8_MMA(1, 0, At, B0); PG8_MMA(1, 1, At, B1); PG8_BAR; PG8_SCHED;
            PG8_LDB(B0, 1, 0); PG8_LDB(B1, 1, 1); PG8_SCHED; PG8_LDA(At, 1, 0); PG8_STAGE(PG8_SA(0, 1), a2 + hstep, voffA);
            PG8_WAIT_V(8); PG8_WAIT_L(0); PG8_BAR; PG8_MMA(0, 0, At, B0); PG8_MMA(0, 1, At, B1); PG8_BAR; PG8_SCHED;
            PG8_LDA(At, 1, 1); PG8_STAGE(PG8_SB(1, 0), b3, voffB); PG8_STAGE(PG8_SB(1, 1), b3 + hstep, voffB); PG8_STAGE(PG8_SA(1, 0), a3, voffA);
            PG8_WAIT_V(8); PG8_WAIT_L(0); PG8_BAR; PG8_MMA(1, 0, At, B0); PG8_MMA(1, 1, At, B1); PG8_BAR; PG8_SCHED;
            } else {
            PG8_LDB(B0, 0, 0); PG8_SCHED; PG8_LDA(At, 0, 0); PG8_STAGE(PG8_SA(1, 1), a1 + hstep, voffA);
            PG8_WAIT_L(8); PG8_BAR; PG8_WAIT_L(0); PG8_MMA(0, 0, At, B0); PG8_BAR; PG8_SCHED;
            PG8_LDB(B1, 0, 1); PG8_STAGE(PG8_SB(0, 0), b2, voffB);
            PG8_BAR; PG8_WAIT_L(0); PG8_MMA(0, 1, At, B1); PG8_BAR;
            PG8_LDA(At, 0, 1); PG8_STAGE(PG8_SA(0, 0), a2, voffA);
            PG8_BAR; PG8_WAIT_L(0); PG8_MMA(1, 0, At, B0); PG8_BAR; PG8_SCHED;
            PG8_STAGE(PG8_SB(0, 1), b2 + hstep, voffB);
            PG8_WAIT_V(6); PG8_BAR; PG8_MMA(1, 1, At, B1); PG8_BAR;
            PG8_LDB(B0, 1, 0); PG8_SCHED; PG8_LDA(At, 1, 0); PG8_STAGE(PG8_SA(0, 1), a2 + hstep, voffA);
            PG8_WAIT_L(8); PG8_BAR; PG8_WAIT_L(0); PG8_MMA(0, 0, At, B0); PG8_BAR; PG8_SCHED;
            PG8_LDB(B1, 1, 1); PG8_STAGE(PG8_SB(1, 0), b3, voffB);
            PG8_BAR; PG8_WAIT_L(0); PG8_MMA(0, 1, At, B1); PG8_BAR;
            PG8_LDA(At, 1, 1); PG8_STAGE(PG8_SA(1, 0), a3, voffA);
            PG8_BAR; PG8_WAIT_L(0); PG8_MMA(1, 0, At, B0); PG8_BAR; PG8_SCHED;
            PG8_STAGE(PG8_SB(1, 1), b3 + hstep, voffB);
            PG8_WAIT_V(6); PG8_BAR; PG8_MMA(1, 1, At, B1); PG8_BAR;
            }
        }
        if constexpr (ALIGN_EPI) { if (wr == 0) PG8_BAR; }
        if constexpr (!Epi::AFTER_DRAIN) { E(acc, cur, wr, wc, fr, fq); S.done(cur); }
        if (!has_next) break;
#pragma unroll
        for (int a = 0; a < 2; ++a)
#pragma unroll
            for (int b = 0; b < 2; ++b)
#pragma unroll
                for (int m = 0; m < 4; ++m)
#pragma unroll
                    for (int n = 0; n < 2; ++n) acc[a][b][m][n] = (f32x4){0.f, 0.f, 0.f, 0.f};
        cur = nxt; cA = nA; cB = nB; ++ui;
        if constexpr (ALIGN_EPI) { if (wr == 1) PG8_BAR; }
    }
    PG8_WAIT_V(0);
    if constexpr (!ALIGN_EPI) { if (wr == 0) PG8_BAR; }
    PG8_BAR;
    if constexpr (Epi::AFTER_DRAIN) { E.fused(acc, cur, wr, wc, fr, fq, lds, wid, lane); S.done(cur); }
#undef PG8_SA
#undef PG8_SB
#undef PG8_STAGE
#undef PG8_LDA
#undef PG8_LDB
#undef PG8_MMA
#undef PG8_WAIT_V
#undef PG8_WAIT_L
#undef PG8_BAR
#undef PG8_SCHED
}
}


template <class Q> struct has_regions { template <class T> static char t(decltype(T::REGIONS)*); template <class T> static long t(...); static constexpr bool value = sizeof(t<Q>(nullptr)) == 1; };
template <class Q, bool PAIR> struct EpiAdapt {
    static constexpr bool PERM = false, AFTER_DRAIN = false;
    Q q; mutable int ucount = 0;
    template <int R> __device__ __forceinline__ void run(const pg8::f32x4 (&acc)[2][2][4][2], const pg8::Unit& u, int wr, int wc, int fr, int fq, int sbuf) const {
#pragma unroll
        for (int ai = 0; ai < 2; ++ai)
#pragma unroll
            for (int m = 0; m < 4; ++m) {
                const int row = u.pm * 256 + ai * 128 + wr * 64 + m * 16 + fr; float ss = 0.f; const float rv = q.rowinit(row, sbuf);
                if constexpr (PAIR) {
#pragma unroll
                    for (int n = 0; n < 2; ++n) q.pair(row, u.pn * 128 + wc * 32 + n * 16 + 4 * fq, acc[ai][0][m][n], acc[ai][1][m][n], rv);
                } else {
#pragma unroll
                    for (int bj = 0; bj < 2; ++bj)
#pragma unroll
                        for (int n = 0; n < 2; ++n) {
                            if constexpr (has_regions<Q>::value) ss += q.template quadr<R>(row, u.pn * 256 + bj * 128 + wc * 32 + n * 16 + 4 * fq, acc[ai][bj][m][n], rv);
                            else ss += q.quad(row, u.pn * 256 + bj * 128 + wc * 32 + n * 16 + 4 * fq, acc[ai][bj][m][n], rv);
                        }
                }
                if constexpr (Q::NEED_SS) { ss += __shfl_xor(ss, 16); ss += __shfl_xor(ss, 32); if (fq == 0) q.rowsum(row, ss); }
            }
    }
    __device__ __forceinline__ void operator()(const pg8::f32x4 (&acc)[2][2][4][2], const pg8::Unit& u, int wr, int wc, int fr, int fq) const {
        const int sbuf = ucount & 1; ++ucount;
        if constexpr (has_regions<Q>::value) {
            const int rg = q.region(u.pn);
            if (rg == 0) run<0>(acc, u, wr, wc, fr, fq, sbuf); else if (rg == 1) run<1>(acc, u, wr, wc, fr, fq, sbuf); else if (rg == 2) run<2>(acc, u, wr, wc, fr, fq, sbuf); else run<3>(acc, u, wr, wc, fr, fq, sbuf);
        } else run<0>(acc, u, wr, wc, fr, fq, sbuf);
    }
};
struct SsOrder : pg8::StaticOrder {
    const float* ss; LAS unsigned char* lds; mutable int ucount = 0;
    __device__ __forceinline__ void a_ready(const pg8::Unit& u) const {
        const int sbuf = ucount & 1; ++ucount;
        const int w = __builtin_amdgcn_readfirstlane((int)threadIdx.x >> 6), lane = threadIdx.x & 63;
        if (w < 4) __builtin_amdgcn_global_load_lds((const unsigned*)(ss + u.pm * 256 + w * 64 + lane), (LAS unsigned*)(lds + SSL_OFF + (sbuf << 10) + (w << 8)), 4, 0, 0);
    }
};
template <bool PAIR, class Q> __device__ __forceinline__ void gemm8s(LAS unsigned char* lds, const bf16* A, const bf16* Bt, int M, int N, int K, const Q& q, const float* ss) {
    pg8::Gemm g{A, Bt, M, N, K}; SsOrder S; S.init(M, N, (int)gridDim.x, (int)blockIdx.x); S.ss = ss; S.lds = lds; S.ucount = 0;
    EpiAdapt<Q, PAIR> E{q, 0};
    pg8::gemm_phase<EpiAdapt<Q, PAIR>, SsOrder, true, true>((PG8_LAS unsigned char*)lds, g, S, E);
}
template <bool PAIR, class Q> __device__ __forceinline__ void gemm8(LAS unsigned char* lds, const bf16* A, const bf16* Bt, int M, int N, int K, const Q& q) {
    pg8::Gemm g{A, Bt, M, N, K}; pg8::StaticOrder S; S.init(M, N, (int)gridDim.x, (int)blockIdx.x);
    EpiAdapt<Q, PAIR> E{q, 0};
    pg8::gemm_phase<EpiAdapt<Q, PAIR>, pg8::StaticOrder, true, true>((PG8_LAS unsigned char*)lds, g, S, E);
}


typedef float f32x16 __attribute__((ext_vector_type(16)));
typedef short s16x4 __attribute__((ext_vector_type(4)));
__device__ __forceinline__ s16x4 tr_read(const LAS unsigned char* p) { return __builtin_bit_cast(s16x4, __builtin_amdgcn_ds_read_tr16_b64_v4i16((LAS s16x4*)p)); }
__device__ __forceinline__ bf16x8 pack8(const f32x4 a, const f32x4 b) { u32x4 w; w.x = cvtpk(a[0], a[1]); w.y = cvtpk(a[2], a[3]); w.z = cvtpk(b[0], b[1]); w.w = cvtpk(b[2], b[3]); return __builtin_bit_cast(bf16x8, w); }
constexpr int DA_SLOT = 36864, DA_BT = 18944;
constexpr int DA_L = 0, DA_B = 2 * DA_SLOT, DA_Q = DA_B + 3 * DA_BT, DA_P = DA_Q + 13824, DA_PG = DA_P + 2 * 5120, DA_SY = DA_PG + 128, DA_END = DA_SY + 16;
static_assert(DA_END <= MISC_OFF && DA_BT % 512 == 0 && DA_B % 512 == 0, "decode LDS map");
constexpr size_t CTL_ZEROS = 786432;

struct DecodeArgs { const float* cache_ckv; const float* cache_kr; const int* pt; const bf16* QRAW; const f32x2_t* ROPET_; const float* GQK; const bf16* WUKVT; const float* new_ckv; const float* new_kr; const float* zeros; float* OP; float* LP; };

__device__ __forceinline__ void decode_attn(LAS unsigned char* lds, const DecodeArgs& D) {
    int tid = threadIdx.x; asm volatile("" : "+v"(tid));
    const int w = __builtin_amdgcn_readfirstlane(tid >> 6);
#define lane0 (tid & 63)
    bf16x8 Wf[2][16];
#pragma unroll
    for (int mt = 0; mt < 2; ++mt)
#pragma unroll
        for (int ks = 0; ks < 16; ++ks) Wf[mt][ks] = *(const bf16x8*)(D.WUKVT + (size_t)(w * 128 + 32 * mt + (lane0 & 31)) * KVL + 16 * ks + 8 * (lane0 >> 5));
    LAS unsigned char* Qp = lds + DA_Q + w * 1728;
    LAS int* PG = (LAS int*)(lds + DA_PG);
    for (int i = lane0; i < 96; i += 64) *(LAS bf16*)(Qp + 8 * 192 + i * 2) = (bf16)0;
    for (int unit = blockIdx.x; unit < 2 * DECB; unit += gridDim.x) {
        const int seq = unit >> 1, half = unit & 1, ntiles = __builtin_amdgcn_readfirstlane(128 + half);
        asm volatile("s_waitcnt vmcnt(0) lgkmcnt(0)" ::: "memory"); __builtin_amdgcn_s_barrier();
        {   int tidu = tid; asm volatile("" : "+v"(tidu)); const int lu = tidu & 63;
        if (tidu < 32) PG[tidu] = D.pt[seq * NPAGES + half * 32 + tidu];
        if (tidu == 0) { *(LAS unsigned*)(lds + DA_SY) = 0u; *(LAS unsigned*)(lds + DA_SY + 4) = 0u; }
        unsigned zz = 0u; asm volatile("" : "+v"(zz));
        for (int i = tidu; i < 5120 / 16; i += NTHREADS) *(LAS u32x4*)(lds + DA_P + 5120 + i * 16) = (u32x4){zz, zz, zz, zz};
        for (int i = tidu; i < DA_BT / 16; i += NTHREADS) *(LAS u32x4*)(lds + DA_B + 2 * DA_BT + i * 16) = (u32x4){zz, zz, zz, zz};
        {
            const int t = lu >> 3, j = lu & 7; const size_t qrow = (size_t)(TP + seq * DECS + t) * (NH * QKH) + w * QKH;
            float v[8]; unpack8(*(const u32x4*)(D.QRAW + qrow + 8 * j), v);
            const unsigned w1 = *(const unsigned*)(D.QRAW + qrow + 64 + 2 * j), w2 = *(const unsigned*)(D.QRAW + qrow + 80 + 2 * j);
            const float x1[2] = {bflo(w1), bfhi(w1)}, x2[2] = {bflo(w2), bfhi(w2)}; float o1[2], o2[2];
#pragma unroll
            for (int e = 0; e < 2; ++e) { const f32x2_t cs = D.ROPET_[(SEQ + t) * 16 + 2 * j + e]; o1[e] = x1[e] * cs.x - x2[e] * cs.y; o2[e] = x1[e] * cs.y + x2[e] * cs.x; }
            float ss = (o1[0] * o1[0] + o1[1] * o1[1]) + (o2[0] * o2[0] + o2[1] * o2[1]);
#pragma unroll
            for (int e = 0; e < 8; ++e) ss += v[e] * v[e];
            ss = sum8(ss);
            const float rq = rsqrtf(ss * (1.0f / QKH) + EPS) * (0.10206207261596575f * 1.4426950408889634f);
            LAS bf16* qp = (LAS bf16*)(Qp + t * 192);
#pragma unroll
            for (int e = 0; e < 8; ++e) { const int d = 8 * j + e;
                const int pos = (d & 48) | (((d >> 2) & 1) << 3) | (((d >> 3) & 1) << 2) | (d & 3);
                qp[pos] = (bf16)f2bf(v[e] * rq * D.GQK[d]); }
#pragma unroll
            for (int e = 0; e < 2; ++e) { qp[64 + 2 * j + e] = (bf16)f2bf(o1[e] * rq * D.GQK[64 + 2 * j + e]); qp[80 + 2 * j + e] = (bf16)f2bf(o2[e] * rq * D.GQK[80 + 2 * j + e]); }
        }
        }
        asm volatile("s_waitcnt vmcnt(0) lgkmcnt(0)" ::: "memory"); __builtin_amdgcn_s_barrier();
        unsigned hz_pv0, hz_pv1, hz_cs, hz_ck, hz_x, hz_kr, hz_q;
        {   int lz = lane0; asm volatile("" : "+v"(lz)); const int rr = lz & 31, hh = lz >> 5, i15 = lz & 15;
            const int col = 32 * w + 16 * ((lz >> 4) & 1) + 4 * (i15 & 3), Pc = col >> 3, hf = (col >> 2) & 1;
            const int k0 = 8 * hh + (i15 >> 2), k1 = k0 + 4; const int sg0 = ((k0 & 3) << 2) | ((k0 >> 2) & 3), sg1 = ((k1 & 3) << 2) | ((k1 >> 2) & 3);
            hz_pv0 = k0 * 512 + ((Pc ^ sg0) << 4) + (hf << 3); hz_pv1 = k1 * 512 + ((Pc ^ sg1) << 4) + (hf << 3);
            hz_cs = ((lz >> 1) << 4) | ((lz & 1) << 3);
            {   const int l31 = lz & 31, key = 4 * w + (l31 >> 3), pc = l31 & 7; hz_ck = 16384 + key * 64 + (((pc >> 1) ^ ((key >> 2) & 3)) << 4) + ((pc & 1) << 3); }
            const int sg = ((rr & 3) << 2) | ((rr >> 2) & 3);
            hz_x = rr * 512 + ((hh ^ sg) << 4);
            hz_kr = 16384 + rr * 64 + ((hh ^ ((rr >> 2) & 3)) << 4);
            hz_q = (rr < 8 ? rr : 8) * 192 + hh * 16;
        }
#define DA_ISSUE(ti) do { const int ti_ = (ti); LAS unsigned char* sl_ = lds + DA_L + (ti_ & 1) * DA_SLOT; int lane = lane0; asm volatile("" : "+v"(lane)); \
            const float* cb_; const float* kb_; int nvalid_ = 32; \
            if (ti_ < 128) { const int pg_ = __builtin_amdgcn_readfirstlane(PG[ti_ >> 2]); const size_t ro_ = (size_t)pg_ * PAGE + (ti_ & 3) * 32; cb_ = D.cache_ckv + ro_ * KVL; kb_ = D.cache_kr + ro_ * ROPE; } \
            else { cb_ = D.new_ckv + (size_t)seq * DECS * KVL; kb_ = D.new_kr + (size_t)seq * DECS * ROPE; nvalid_ = DECS; } \
            _Pragma("unroll") for (int c_ = 0; c_ < 4; ++c_) { const int key_ = 4 * w + c_; \
                const float* src_ = (key_ < nvalid_) ? cb_ + (size_t)key_ * KVL + (lane << 2) : D.zeros + (lane << 2); \
                __builtin_amdgcn_global_load_lds((const unsigned*)src_, (LAS unsigned*)(sl_ + key_ * 1024), 16, 0, 0); } \
            { const int l31_ = lane & 31, key_ = 4 * w + (l31_ >> 3); \
              const float* src_ = (key_ < nvalid_) ? kb_ + (size_t)key_ * ROPE + ((l31_ & 7) << 2) : D.zeros + (l31_ << 2); \
              if (lane < 32) __builtin_amdgcn_global_load_lds((const unsigned*)src_, (LAS unsigned*)(sl_ + 32768 + w * 512), 16, 0, 0); } \
        } while (0)
#define DA_ISSUE_PG(ti, pgv_) do { const int ti_ = (ti); LAS unsigned char* sl_ = lds + DA_L + (ti_ & 1) * DA_SLOT; int lane = lane0; asm volatile("" : "+v"(lane)); \
            const float* cb_; const float* kb_; int nvalid_ = 32; \
            if (ti_ < 128) { const int pg_ = __builtin_amdgcn_readfirstlane(pgv_); const size_t ro_ = (size_t)pg_ * PAGE + (ti_ & 3) * 32; cb_ = D.cache_ckv + ro_ * KVL; kb_ = D.cache_kr + ro_ * ROPE; } \
            else { cb_ = D.new_ckv + (size_t)seq * DECS * KVL; kb_ = D.new_kr + (size_t)seq * DECS * ROPE; nvalid_ = DECS; } \
            _Pragma("unroll") for (int c_ = 0; c_ < 4; ++c_) { const int key_ = 4 * w + c_; \
                const float* src_ = (key_ < nvalid_) ? cb_ + (size_t)key_ * KVL + (lane << 2) : D.zeros + (lane << 2); \
                __builtin_amdgcn_global_load_lds((const unsigned*)src_, (LAS unsigned*)(sl_ + key_ * 1024), 16, 0, 0); } \
            { const int l31_ = lane & 31, key_ = 4 * w + (l31_ >> 3); \
              const float* src_ = (key_ < nvalid_) ? kb_ + (size_t)key_ * ROPE + ((l31_ & 7) << 2) : D.zeros + (l31_ << 2); \
              if (lane < 32) __builtin_amdgcn_global_load_lds((const unsigned*)src_, (LAS unsigned*)(sl_ + 32768 + w * 512), 16, 0, 0); } \
        } while (0)
#define DA_CVT_LOAD(ti) do { const int ti_ = (ti); const LAS unsigned char* sl_ = lds + DA_L + (ti_ & 1) * DA_SLOT; int lane = lane0; asm volatile("" : "+v"(lane)); \
            _Pragma("unroll") for (int c_ = 0; c_ < 4; ++c_) cvr[c_] = *(const LAS f32x4*)(sl_ + (4 * w + c_) * 1024 + lane * 16); \
            cvr[4] = *(const LAS f32x4*)(sl_ + 32768 + (4 * w + ((lane & 31) >> 3)) * 128 + (lane & 7) * 16); } while (0)
#define DA_CVT_STORE(bt_) do { \
            _Pragma("unroll") for (int c_ = 0; c_ < 4; ++c_) { const int key_ = 4 * w + c_, sg_ = ((key_ & 3) << 2) | ((key_ >> 2) & 3); u32x2 o_; o_.x = cvtpk(cvr[c_][0], cvr[c_][1]); o_.y = cvtpk(cvr[c_][2], cvr[c_][3]); \
                *(LAS u32x2*)((bt_) + key_ * 512 + (hz_cs ^ (unsigned)(sg_ << 4))) = o_; } \
            { u32x2 o_; o_.x = cvtpk(cvr[4][0], cvr[4][1]); o_.y = cvtpk(cvr[4][2], cvr[4][3]); \
              if (lane0 < 32) *(LAS u32x2*)((bt_) + hz_ck) = o_; \
              const float q_ = sum8((cvr[4][0] * cvr[4][0] + cvr[4][1] * cvr[4][1]) + (cvr[4][2] * cvr[4][2] + cvr[4][3] * cvr[4][3])) + (float)QKH * EPS;     \
              if ((lane0 & 0x27) == 0) *(LAS float*)((bt_) + 18432 + 16 * w + ((lane0 >> 3) << 2)) = q_; } } while (0)
        DA_ISSUE(0); DA_ISSUE(1);
        asm volatile("s_waitcnt vmcnt(5)" ::: "memory");
        { f32x4 cvr[5]; DA_CVT_LOAD(0); DA_CVT_STORE(lds + DA_B); }
        asm volatile("s_waitcnt lgkmcnt(0)" ::: "memory");
        DA_ISSUE(2);
        __builtin_amdgcn_s_barrier(); asm volatile("" ::: "memory");
        f32x16 O0, O1;
#pragma unroll
        for (int e = 0; e < 16; ++e) { O0[e] = 0.f; O1[e] = 0.f; }
        float ls0 = 0.f, ls1 = 0.f, ls2 = 0.f, ls3 = 0.f;
        int bprev = 2 * DA_BT, bcur = 0, bnext = DA_BT;
#define DA_PV_LOAD(bt_) do { const unsigned a0 = (unsigned)(unsigned long)(bt_) + hz_pv0, a1 = (unsigned)(unsigned long)(bt_) + hz_pv1; \
            asm volatile("ds_read_b64_tr_b16 %0, %1" : "=&v"(c00) : "v"(a0)); asm volatile("ds_read_b64_tr_b16 %0, %1" : "=&v"(c01) : "v"(a1)); \
            asm volatile("ds_read_b64_tr_b16 %0, %1 offset:8192" : "=&v"(c10) : "v"(a0)); asm volatile("ds_read_b64_tr_b16 %0, %1 offset:8192" : "=&v"(c11) : "v"(a1)); \
            } while (0)
#define DA_PV_MMA(pb_) do { int lnB = lane0; asm volatile("" : "+v"(lnB)); const int rr = lnB & 31, hh = lnB >> 5; \
            { const bf16x8 cf0 = (bf16x8){c00[0], c00[1], c00[2], c00[3], c01[0], c01[1], c01[2], c01[3]}; \
              const bf16x8 pa0 = *(const LAS bf16x8*)((pb_) + rr * 80 + (8 * hh) * 2), pb0 = *(const LAS bf16x8*)((pb_) + (32 + rr) * 80 + (8 * hh) * 2); \
              O0 = __builtin_amdgcn_mfma_f32_32x32x16_bf16(pa0, cf0, O0, 0, 0, 0); O1 = __builtin_amdgcn_mfma_f32_32x32x16_bf16(pb0, cf0, O1, 0, 0, 0); } \
            { const bf16x8 cf1 = (bf16x8){c10[0], c10[1], c10[2], c10[3], c11[0], c11[1], c11[2], c11[3]}; \
              const bf16x8 pa1 = *(const LAS bf16x8*)((pb_) + rr * 80 + (16 + 8 * hh) * 2), pb1 = *(const LAS bf16x8*)((pb_) + (32 + rr) * 80 + (16 + 8 * hh) * 2); \
              O0 = __builtin_amdgcn_mfma_f32_32x32x16_bf16(pa1, cf1, O0, 0, 0, 0); O1 = __builtin_amdgcn_mfma_f32_32x32x16_bf16(pb1, cf1, O1, 0, 0, 0); } } while (0)
#define DA_XRD(dst_, ks_) asm volatile("ds_read_b128 %0, %1 offset:%2" : "=v"(dst_) : "v"(xb ^ (32u * ((ks_) & 7))), "n"(256 * ((ks_) >> 3)))
#define DA_LRD(dst_, addr_, off_) asm volatile("ds_read_b128 %0, %1 offset:%2" : "=v"(dst_) : "v"((unsigned)(unsigned long)(addr_)), "n"(off_))
#define DA_KS(kk_) (((kk_) >> 1) + 8 * ((kk_) & 1))
#define DA_SPIN(off_, target_) do { unsigned v_; const unsigned sa_ = (unsigned)(unsigned long)(lds + DA_SY + (off_)); \
            do { asm volatile("ds_read_b32 %0, %1\n\ts_waitcnt lgkmcnt(0)" : "=v"(v_) : "v"(sa_) : "memory"); } while ((unsigned)__builtin_amdgcn_readfirstlane((int)v_) < (unsigned)(target_)); } while (0)
#define DA_SIGNAL(off_) do { const unsigned sa_ = (unsigned)(unsigned long)(lds + DA_SY + (off_)), one_ = 1u; if (lane0 == 0) asm volatile("ds_add_u32 %0, %1" :: "v"(sa_), "v"(one_) : "memory"); } while (0)
        for (int ti = 0; ti < ntiles; ++ti) {
            const LAS unsigned char* bt = lds + DA_B + bcur;
            LAS unsigned char* Pb = lds + DA_P + (ti & 1) * 5120;
            LAS unsigned char* bn = lds + DA_B + bnext;
            const unsigned xb = (unsigned)(unsigned long)bt + hz_x;
            bf16x8 bq[4]; f32x4 cvr[5]; s16x4 c00, c01, c10, c11;
            unsigned cs_, la_;
            {   int lz = lane0; asm volatile("" : "+v"(lz)); cs_ = ((lz >> 1) << 4) | ((lz & 1) << 3);
                const unsigned slc = (unsigned)(unsigned long)(lds + DA_L + ((ti + 1) & 1) * DA_SLOT);
                la_ = slc + 4 * w * 1024 + lz * 16; }
            if (ti > 0) DA_SPIN(0, 8 * ti);
            if (ti + 2 < ntiles) asm volatile("s_waitcnt vmcnt(5)" ::: "memory"); else asm volatile("s_waitcnt vmcnt(0)" ::: "memory");
            const int pgv = PG[(ti + 3) >> 2];
            DA_XRD(bq[0], DA_KS(0)); DA_XRD(bq[1], DA_KS(1)); DA_XRD(bq[2], DA_KS(2));
            asm volatile("s_waitcnt lgkmcnt(0)" : "+v"(bq[0]), "+v"(bq[1]), "+v"(bq[2]) :: "memory");
#define DA_CROW(c_) do { const int key_ = 4 * w + (c_), sg_ = ((key_ & 3) << 2) | ((key_ >> 2) & 3); u32x2 o_; o_.x = cvtpk(cvr[c_][0], cvr[c_][1]); o_.y = cvtpk(cvr[c_][2], cvr[c_][3]); \
                *(LAS u32x2*)(bn + key_ * 512 + (cs_ ^ (unsigned)(sg_ << 4))) = o_; } while (0)
#define DA_CVRD(c_) asm volatile("ds_read_b128 %0, %1 offset:%2" : "=v"(cvr[c_]) : "v"(la_), "n"(1024 * (c_)))
#define DA_WAITV(n_, v_) asm volatile("s_waitcnt lgkmcnt(%1)" : "+v"(v_) : "n"(n_))
            f32x16 X0, X1; const f32x16 Z16 = {0.f, 0.f, 0.f, 0.f, 0.f, 0.f, 0.f, 0.f, 0.f, 0.f, 0.f, 0.f, 0.f, 0.f, 0.f, 0.f};
            u32x4 kw0, kw1; bf16x8 qf[3]; float ssk;
            const float* cb_ = nullptr; const float* kb_ = nullptr; int nvalid_ = 32; LAS unsigned char* sl_ = lds + DA_L + ((ti + 3) & 1) * DA_SLOT;
            const bool dma_ = ti + 3 < ntiles;
            __builtin_amdgcn_s_setprio(1);
#pragma unroll
            for (int kk = 0; kk < 16; ++kk) {
                const int ks = DA_KS(kk);
                if (kk + 3 < 16) DA_XRD(bq[(kk + 3) % 4], DA_KS(kk + 3));
                if (kk < 4) DA_CVRD(kk);
                if (kk == 4) { int lz = lane0; asm volatile("" : "+v"(lz)); const unsigned lk_ = (unsigned)(unsigned long)(lds + DA_L + ((ti + 1) & 1) * DA_SLOT) + 32768 + (4 * w + ((lz & 31) >> 3)) * 128 + (lz & 7) * 16;
                    asm volatile("ds_read_b128 %0, %1" : "=v"(cvr[4]) : "v"(lk_)); }
                if (kk == 15) { int lz = lane0; asm volatile("" : "+v"(lz)); asm volatile("ds_read_b32 %0, %1 offset:18432" : "=v"(ssk) : "v"((unsigned)(unsigned long)bt + ((lz & 31) << 2))); }
                if (kk == 3 || kk == 4) DA_WAITV(7, bq[kk % 4]);
                if (kk == 5) DA_WAITV(6, bq[kk % 4]);
                if (kk == 6) DA_WAITV(5, bq[kk % 4]);
                if (kk == 7) DA_WAITV(4, bq[kk % 4]);
                if (kk >= 8 && kk <= 12) DA_WAITV(3, bq[kk % 4]);
                if (kk == 13) DA_WAITV(2, bq[kk % 4]);
                if (kk == 14) DA_WAITV(5, bq[kk % 4]);
                if (kk == 15) asm volatile("s_waitcnt lgkmcnt(1)" : "+v"(bq[kk % 4]), "+v"(c00), "+v"(c01), "+v"(c10), "+v"(c11));
                X0 = __builtin_amdgcn_mfma_f32_32x32x16_bf16(Wf[0][ks], bq[kk % 4], kk == 0 ? Z16 : X0, 0, 0, 0);
                X1 = __builtin_amdgcn_mfma_f32_32x32x16_bf16(Wf[1][ks], bq[kk % 4], kk == 0 ? Z16 : X1, 0, 0, 0);
                if (kk >= 2 && kk <= 4) { DA_WAITV(4, cvr[kk - 2]); DA_CROW(kk - 2); }
                if (kk == 5) { DA_WAITV(3, cvr[3]); DA_CROW(3); }
                if (kk == 6) { DA_WAITV(2, cvr[4]); u32x2 o_; o_.x = cvtpk(cvr[4][0], cvr[4][1]); o_.y = cvtpk(cvr[4][2], cvr[4][3]);
                    {   int lz = lane0; asm volatile("" : "+v"(lz)); const int l31 = lz & 31, key = 4 * w + (l31 >> 3), pc = l31 & 7; const unsigned ck_ = 16384 + key * 64 + (((pc >> 1) ^ ((key >> 2) & 3)) << 4) + ((pc & 1) << 3);
                        if (lz < 32) *(LAS u32x2*)(bn + ck_) = o_; }
                    const float q_ = sum8((cvr[4][0] * cvr[4][0] + cvr[4][1] * cvr[4][1]) + (cvr[4][2] * cvr[4][2] + cvr[4][3] * cvr[4][3])) + (float)QKH * EPS;
                    if ((lane0 & 0x27) == 0) *(LAS float*)(bn + 18432 + 16 * w + ((lane0 >> 3) << 2)) = q_; }
                if (kk == 7 && dma_) { const int ti_ = ti + 3;
                    if (ti_ < 128) { const int pg_ = __builtin_amdgcn_readfirstlane(pgv); const size_t ro_ = (size_t)pg_ * PAGE + (ti_ & 3) * 32; cb_ = D.cache_ckv + ro_ * KVL; kb_ = D.cache_kr + ro_ * ROPE; }
                    else { cb_ = D.new_ckv + (size_t)seq * DECS * KVL; kb_ = D.new_kr + (size_t)seq * DECS * ROPE; nvalid_ = DECS; } }
                if (kk >= 8 && kk <= 11 && dma_) { const int c_ = kk - 8, key_ = 4 * w + c_; int lane = lane0; asm volatile("" : "+v"(lane));
                    const float* src_ = (key_ < nvalid_) ? cb_ + (size_t)key_ * KVL + (lane << 2) : D.zeros + (lane << 2);
                    __builtin_amdgcn_global_load_lds((const unsigned*)src_, (LAS unsigned*)(sl_ + key_ * 1024), 16, 0, 0); }
                if (kk == 12 && dma_) { int lane = lane0; asm volatile("" : "+v"(lane)); const int l31_ = lane & 31, key_ = 4 * w + (l31_ >> 3);
                    const float* src_ = (key_ < nvalid_) ? kb_ + (size_t)key_ * ROPE + ((l31_ & 7) << 2) : D.zeros + (l31_ << 2);
                    if (lane < 32) __builtin_amdgcn_global_load_lds((const unsigned*)src_, (LAS unsigned*)(sl_ + 32768 + w * 512), 16, 0, 0); }
                if (kk == 13) { int lz = lane0; asm volatile("" : "+v"(lz)); const int hh = lz >> 5, i15 = lz & 15, col = 32 * w + 16 * ((lz >> 4) & 1) + 4 * (i15 & 3), Pc = col >> 3, hf = (col >> 2) & 1;
                    const int k0 = 8 * hh + (i15 >> 2), k1 = k0 + 4; const int sg0 = ((k0 & 3) << 2) | ((k0 >> 2) & 3), sg1 = ((k1 & 3) << 2) | ((k1 >> 2) & 3);
                    const unsigned a0 = (unsigned)(unsigned long)(lds + DA_B + bprev) + k0 * 512 + ((Pc ^ sg0) << 4) + (hf << 3), a1 = (unsigned)(unsigned long)(lds + DA_B + bprev) + k1 * 512 + ((Pc ^ sg1) << 4) + (hf << 3);
                    asm volatile("ds_read_b64_tr_b16 %0, %1" : "=&v"(c00) : "v"(a0)); asm volatile("ds_read_b64_tr_b16 %0, %1" : "=&v"(c01) : "v"(a1));
                    asm volatile("ds_read_b64_tr_b16 %0, %1 offset:8192" : "=&v"(c10) : "v"(a0)); asm volatile("ds_read_b64_tr_b16 %0, %1 offset:8192" : "=&v"(c11) : "v"(a1)); }
            }
            __builtin_amdgcn_s_setprio(0);
#undef DA_CROW
#undef DA_CVRD
#undef DA_WAITV
            DA_SIGNAL(0);
            unsigned hq_, hk_; { int lq = lane0; asm volatile("" : "+v"(lq)); const int rr = lq & 31, hh = lq >> 5; hq_ = (rr < 8 ? rr : 8) * 192 + hh * 16; hk_ = 16384 + rr * 64 + ((hh ^ ((rr >> 2) & 3)) << 4); }
            DA_LRD(qf[0], Qp + hq_, 0); DA_LRD(qf[1], Qp + hq_, 64); DA_LRD(qf[2], Qp + hq_, 128); DA_LRD(kw0, bt + hk_, 0);
            f32x2_t ss2 = {0.f, 0.f};
#pragma unroll
            for (int e = 0; e < 16; e += 2) { const f32x2_t a = {X0[e], X0[e + 1]}, b = {X1[e], X1[e + 1]}; ss2 += a * a; ss2 += b * b; }
            float ss = ss2.x + ss2.y;
            asm volatile("s_waitcnt lgkmcnt(4)" : "+v"(ssk));
            ss = xor32_sum(ss) + ssk;
            const float rinv = rsqrtf(ss * (1.0f / QKH));
            f32x16 S;
            {   const bf16x8 xa = pack8((f32x4){X0[0], X0[1], X0[2], X0[3]}, (f32x4){X0[4], X0[5], X0[6], X0[7]});
                const bf16x8 xc = pack8((f32x4){X1[0], X1[1], X1[2], X1[3]}, (f32x4){X1[4], X1[5], X1[6], X1[7]});
                asm volatile("s_waitcnt lgkmcnt(0)" : "+v"(qf[0]), "+v"(qf[1]), "+v"(qf[2]), "+v"(kw0));
                S = __builtin_amdgcn_mfma_f32_32x32x16_bf16(qf[0], xa, Z16, 0, 0, 0);
                S = __builtin_amdgcn_mfma_f32_32x32x16_bf16(qf[1], xc, S, 0, 0, 0);
                S = __builtin_amdgcn_mfma_f32_32x32x16_bf16(qf[2], __builtin_bit_cast(bf16x8, kw0), S, 0, 0, 0); }
            {   bf16x8 qg[3];
                DA_LRD(qg[0], Qp + hq_, 32); DA_LRD(qg[1], Qp + hq_, 96); DA_LRD(qg[2], Qp + hq_, 160); DA_LRD(kw1, bt + (hk_ ^ 32u), 0);
                const bf16x8 xa = pack8((f32x4){X0[8], X0[9], X0[10], X0[11]}, (f32x4){X0[12], X0[13], X0[14], X0[15]});
                const bf16x8 xc = pack8((f32x4){X1[8], X1[9], X1[10], X1[11]}, (f32x4){X1[12], X1[13], X1[14], X1[15]});
                asm volatile("s_waitcnt lgkmcnt(0)" : "+v"(qg[0]), "+v"(qg[1]), "+v"(qg[2]), "+v"(kw1));
                S = __builtin_amdgcn_mfma_f32_32x32x16_bf16(qg[0], xa, S, 0, 0, 0);
                S = __builtin_amdgcn_mfma_f32_32x32x16_bf16(qg[1], xc, S, 0, 0, 0);
                S = __builtin_amdgcn_mfma_f32_32x32x16_bf16(qg[2], __builtin_bit_cast(bf16x8, kw1), S, 0, 0, 0); }
            float p0v = __builtin_amdgcn_exp2f(S[0] * rinv), p1v = __builtin_amdgcn_exp2f(S[1] * rinv), p2v = __builtin_amdgcn_exp2f(S[2] * rinv), p3v = __builtin_amdgcn_exp2f(S[3] * rinv);
            if (ti >= 128) { int lnA = lane0; asm volatile("; causal mask of the new-token tile" : "+v"(lnA)); const int r = lnA & 31, t0 = 4 * (lnA >> 5); p0v = (r <= t0) ? p0v : 0.f; p1v = (r <= t0 + 1) ? p1v : 0.f; p2v = (r <= t0 + 2) ? p2v : 0.f; p3v = (r <= t0 + 3) ? p3v : 0.f; }
            ls0 += p0v; ls1 += p1v; ls2 += p2v; ls3 += p3v;
            if (ti > 0) DA_SPIN(4, 8 * ti);
            {   bf16x8 pa0, pb0, pa1, pb1;
                {   int lnB = lane0; asm volatile("" : "+v"(lnB)); const LAS unsigned char* pp = lds + DA_P + ((ti + 1) & 1) * 5120 + (lnB & 31) * 80 + (lnB >> 5) * 16;
                    DA_LRD(pa0, pp, 0); DA_LRD(pb0, pp, 2560); DA_LRD(pa1, pp, 32); DA_LRD(pb1, pp, 2592); }
                asm volatile("s_waitcnt lgkmcnt(0)" : "+v"(pa0), "+v"(pb0), "+v"(pa1), "+v"(pb1) :: "memory");
                const bf16x8 cf0 = (bf16x8){c00[0], c00[1], c00[2], c00[3], c01[0], c01[1], c01[2], c01[3]};
                O0 = __builtin_amdgcn_mfma_f32_32x32x16_bf16(pa0, cf0, O0, 0, 0, 0); O1 = __builtin_amdgcn_mfma_f32_32x32x16_bf16(pb0, cf0, O1, 0, 0, 0);
                const bf16x8 cf1 = (bf16x8){c10[0], c10[1], c10[2], c10[3], c11[0], c11[1], c11[2], c11[3]};
                O0 = __builtin_amdgcn_mfma_f32_32x32x16_bf16(pa1, cf1, O0, 0, 0, 0); O1 = __builtin_amdgcn_mfma_f32_32x32x16_bf16(pb1, cf1, O1, 0, 0, 0); }
            {   int lnW = lane0; asm volatile("" : "+v"(lnW)); LAS unsigned char* pw = Pb + ((w * 8 + 4 * (lnW >> 5)) * 80 + (lnW & 31) * 2);
                *(LAS bf16*)(pw) = (bf16)(cvtpk(p0v, 0.f) & 0xffffu); *(LAS bf16*)(pw + 80) = (bf16)(cvtpk(p1v, 0.f) & 0xffffu);
                *(LAS bf16*)(pw + 160) = (bf16)(cvtpk(p2v, 0.f) & 0xffffu); *(LAS bf16*)(pw + 240) = (bf16)(cvtpk(p3v, 0.f) & 0xffffu); }
            asm volatile("" ::: "memory");
            DA_SIGNAL(4);
            { const int t_ = bprev; bprev = bcur; bcur = bnext; bnext = t_; }
        }
        DA_SPIN(4, 8 * ntiles);
#undef DA_KS
        {   s16x4 c00, c01, c10, c11;
            {   int lz = lane0; asm volatile("" : "+v"(lz)); const int hh = lz >> 5, i15 = lz & 15, col = 32 * w + 16 * ((lz >> 4) & 1) + 4 * (i15 & 3), Pc = col >> 3, hf = (col >> 2) & 1;
                const int k0 = 8 * hh + (i15 >> 2), k1 = k0 + 4; const int sg0 = ((k0 & 3) << 2) | ((k0 >> 2) & 3), sg1 = ((k1 & 3) << 2) | ((k1 >> 2) & 3);
                const unsigned a0 = (unsigned)(unsigned long)(lds + DA_B + bprev) + k0 * 512 + ((Pc ^ sg0) << 4) + (hf << 3), a1 = (unsigned)(unsigned long)(lds + DA_B + bprev) + k1 * 512 + ((Pc ^ sg1) << 4) + (hf << 3);
                asm volatile("ds_read_b64_tr_b16 %0, %1" : "=&v"(c00) : "v"(a0)); asm volatile("ds_read_b64_tr_b16 %0, %1" : "=&v"(c01) : "v"(a1));
                asm volatile("ds_read_b64_tr_b16 %0, %1 offset:8192" : "=&v"(c10) : "v"(a0)); asm volatile("ds_read_b64_tr_b16 %0, %1 offset:8192" : "=&v"(c11) : "v"(a1)); }
            asm volatile("s_waitcnt lgkmcnt(0)" : "+v"(c00), "+v"(c01), "+v"(c10), "+v"(c11) :: "memory");
            DA_PV_MMA(lds + DA_P + ((ntiles - 1) & 1) * 5120); }
        {   int lnE = lane0, unE = unit; asm volatile("" : "+v"(lnE), "+s"(unE));
            const int r = lnE & 31, hi = lnE >> 5;
            float* op = D.OP + (size_t)unE * 64 * KVL + 32 * w + r;
#pragma unroll
            for (int e = 0; e < 16; ++e) { const int row = (e & 3) + 8 * (e >> 2) + 4 * hi; op[(size_t)row * KVL] = O0[e]; op[(size_t)(32 + row) * KVL] = O1[e]; }
#pragma unroll
            for (int o = 1; o < 32; o <<= 1) { const int pa_ = (lnE ^ o) << 2;
#define DA_SX(v_) __builtin_bit_cast(float, __builtin_amdgcn_ds_bpermute(pa_, __builtin_bit_cast(int, v_)))
                ls0 += DA_SX(ls0); ls1 += DA_SX(ls1); ls2 += DA_SX(ls2); ls3 += DA_SX(ls3); }
#undef DA_SX
            if (r == 0) { float* lp = D.LP + (size_t)unE * 64 + w * 8 + 4 * hi; lp[0] = ls0; lp[1] = ls1; lp[2] = ls2; lp[3] = ls3; }
        }
#undef DA_ISSUE
#undef DA_ISSUE_PG
#undef DA_XRD
#undef DA_LRD
#undef DA_CVT_LOAD
#undef DA_CVT_STORE
#undef DA_PV_LOAD
#undef DA_PV_MMA
#undef DA_SPIN
#undef DA_SIGNAL
    }
    asm volatile("s_waitcnt vmcnt(0) lgkmcnt(0)" ::: "memory"); __builtin_amdgcn_s_barrier();
#undef lane0
}
__device__ __forceinline__ void decode_combine(LAS unsigned char* lds, const float* __restrict__ OP, const float* __restrict__ LP, const bf16* __restrict__ WUKVT, bf16* __restrict__ Ob) {
    int tid = threadIdx.x; asm volatile("" : "+v"(tid));
    const int lane = tid & 63, w = __builtin_amdgcn_readfirstlane(tid >> 6), r = lane & 31, hi = lane >> 5, n = w & 1, kq = w >> 1;
    LAS float* PT = (LAS float*)lds;
    for (int u = blockIdx.x; u < 256; u += gridDim.x) {
        const int h = u & 7, sgp = u >> 3, seq = 4 * sgp + (r >> 3), t = r & 7;
        const size_t ro0 = ((size_t)(2 * seq) * 64 + h * 8 + t), ro1 = ro0 + 64;
        const float il = 1.0f / (LP[ro0] + LP[ro1]);
        f32x16 D;
#pragma unroll
        for (int e = 0; e < 16; ++e) D[e] = 0.f;
        f32x4 x0[4], x1[4], y0[4], y1[4]; bf16x8 bw[4];
#pragma unroll
        for (int q = 0; q < 4; ++q) { const int c = 16 * (4 * kq + q) + 8 * hi;
            x0[q] = *(const f32x4*)(OP + ro0 * KVL + c); x1[q] = *(const f32x4*)(OP + ro0 * KVL + c + 4);
            y0[q] = *(const f32x4*)(OP + ro1 * KVL + c); y1[q] = *(const f32x4*)(OP + ro1 * KVL + c + 4);
            bw[q] = *(const bf16x8*)(WUKVT + (size_t)(h * 128 + 64 + 32 * n + r) * KVL + c); }
#pragma unroll
        for (int q = 0; q < 4; ++q) D = __builtin_amdgcn_mfma_f32_32x32x16_bf16(pack8((x0[q] + y0[q]) * il, (x1[q] + y1[q]) * il), bw[q], D, 0, 0, 0);
        __syncthreads();
#pragma unroll
        for (int e = 0; e < 16; ++e) PT[w * 1024 + ((e & 3) + 8 * (e >> 2) + 4 * hi) * 32 + r] = D[e];
        __syncthreads();
        if (w < 2) {
#pragma unroll
            for (int e = 0; e < 16; ++e) { const int row = (e & 3) + 8 * (e >> 2) + 4 * hi; const int o = row * 32 + r;
                const float v = (PT[w * 1024 + o] + PT[(w + 2) * 1024 + o]) + (PT[(w + 4) * 1024 + o] + PT[(w + 6) * 1024 + o]);
                Ob[(size_t)(TP + (4 * sgp + (row >> 3)) * DECS + (row & 7)) * AW + h * VD + 32 * w + r] = (bf16)f2bf(v); }
        }
    }
    __syncthreads();
}

constexpr int PA_KP = 208, PA_VP = 192, PA_KB = 64 * PA_KP, PA_VB = 64 * PA_VP, PA_STAGE = PA_KB + PA_VB, PA_LS = 2 * PA_STAGE;

__device__ __forceinline__ void prompt_attn(LAS unsigned char* lds, const bf16* __restrict__ QRAW, const bf16* __restrict__ KVR, const bf16* __restrict__ KRb, const f32x2_t* __restrict__ ROPET_, const float* __restrict__ GQK, bf16* __restrict__ Ob) {
    int tid = threadIdx.x; asm volatile("" : "+v"(tid));
    const int lane = tid & 63, w = __builtin_amdgcn_readfirstlane(tid >> 6), r = lane & 31, hi = lane >> 5;
    LAS float* LS = (LAS float*)(lds + PA_LS) + w * 32;
    for (int pi = blockIdx.x; pi < 256; pi += gridDim.x) {
        const int bh = pi >> 3, b = bh >> 3, h = bh & 7;
#pragma unroll 1
        for (int uu = 0; uu < 2; ++uu) {
            const int qb = uu == 0 ? (pi & 7) : 15 - (pi & 7);
            const size_t rowbase = (size_t)b * SEQ; const int Q0 = qb * 256, NT = 4 * (qb + 1);
            const int q_glob = Q0 + 32 * w + r;
            bf16x8 qf[6];
            {   float qv[6][8];
#pragma unroll
                for (int ks = 0; ks < 6; ++ks) unpack8(*(const u32x4*)(QRAW + (rowbase + q_glob) * (NH * QKH) + h * QKH + 16 * ks + 8 * hi), qv[ks]);
                float ss = 0.f;
#pragma unroll
                for (int j = 0; j < 8; ++j) { const f32x2_t cs = ROPET_[q_glob * 16 + 8 * hi + j]; const float x1 = qv[4][j], x2 = qv[5][j]; qv[4][j] = x1 * cs.x - x2 * cs.y; qv[5][j] = x1 * cs.y + x2 * cs.x; }
#pragma unroll
                for (int ks = 0; ks < 6; ++ks)
#pragma unroll
                    for (int j = 0; j < 8; ++j) ss += qv[ks][j] * qv[ks][j];
                ss = xor32_sum(ss);
                const float rq = rsqrtf(ss * (1.0f / QKH) + EPS) * (0.10206207261596575f * 1.4426950408889634f);
#pragma unroll
                for (int ks = 0; ks < 6; ++ks) { const f32x4 g0 = *(const f32x4*)(GQK + 16 * ks + 8 * hi), g1 = *(const f32x4*)(GQK + 16 * ks + 8 * hi + 4);
                    qf[ks] = pack8((f32x4){qv[ks][0], qv[ks][1], qv[ks][2], qv[ks][3]} * g0 * rq, (f32x4){qv[ks][4], qv[ks][5], qv[ks][6], qv[ks][7]} * g1 * rq); }
            }
            const int sp = tid & 7;
            const bf16* gk0 = KVR + (rowbase + (tid >> 3)) * 1024 + h * 128 + sp * 8;
            const bf16* gv0 = gk0 + 64;
            const bf16* gk1 = KRb + (rowbase + (tid >> 3)) * ROPE + (sp & 3) * 8;
            const int lk0 = (tid >> 3) * PA_KP + sp * 16, lv0 = PA_KB + (tid >> 3) * PA_VP + sp * 16, lk1 = (tid >> 3) * PA_KP + 128 + (sp & 3) * 16;
            u32x4 sk0 = *(const u32x4*)gk0, sv0 = *(const u32x4*)gv0, sk1 = *(const u32x4*)gk1;
#define PA_NORMK() do { float f0[8], f1[8]; unpack8(sk0, f0); unpack8(sk1, f1); f32x2_t s2_ = {0.f, 0.f}; \
                _Pragma("unroll") for (int e = 0; e < 8; e += 2) { const f32x2_t a_ = {f0[e], f0[e + 1]}; s2_ += a_ * a_; } \
                if (sp < 4) { _Pragma("unroll") for (int e = 0; e < 8; e += 2) { const f32x2_t a_ = {f1[e], f1[e + 1]}; s2_ += a_ * a_; } } \
                float ss_ = s2_.x + s2_.y; ss_ = sum8(ss_); const float rk_ = rsqrtf(ss_ * (1.0f / QKH) + EPS); \
                sk0.x = cvtpk(f0[0] * rk_, f0[1] * rk_); sk0.y = cvtpk(f0[2] * rk_, f0[3] * rk_); sk0.z = cvtpk(f0[4] * rk_, f0[5] * rk_); sk0.w = cvtpk(f0[6] * rk_, f0[7] * rk_); \
                sk1.x = cvtpk(f1[0] * rk_, f1[1] * rk_); sk1.y = cvtpk(f1[2] * rk_, f1[3] * rk_); sk1.z = cvtpk(f1[4] * rk_, f1[5] * rk_); sk1.w = cvtpk(f1[6] * rk_, f1[7] * rk_); } while (0)
            PA_NORMK();
            __syncthreads();
            *(LAS u32x4*)(lds + lk0) = sk0; *(LAS u32x4*)(lds + lv0) = sv0; if (sp < 4) *(LAS u32x4*)(lds + lk1) = sk1;
            __syncthreads();
            f32x16 O0, O1;
#pragma unroll
            for (int e = 0; e < 16; ++e) { O0[e] = 0.f; O1[e] = 0.f; }
            f32x2_t lsum2 = {0.f, 0.f};
            for (int j = 0; j < NT; ++j) {
                const LAS unsigned char* st = lds + (j & 1) * PA_STAGE;
                if (j + 1 < NT) { const size_t o = (size_t)(j + 1) * 64; sk0 = *(const u32x4*)(gk0 + o * 1024); sv0 = *(const u32x4*)(gv0 + o * 1024); sk1 = *(const u32x4*)(gk1 + o * ROPE); }
                if (64 * j <= Q0 + 32 * w + 31) {
                    f32x16 S0, S1; const f32x16 Z16 = {0.f, 0.f, 0.f, 0.f, 0.f, 0.f, 0.f, 0.f, 0.f, 0.f, 0.f, 0.f, 0.f, 0.f, 0.f, 0.f};
#pragma unroll
                    for (int ks = 0; ks < 6; ++ks) {
                        const bf16x8 k0 = *(const LAS bf16x8*)(st + r * PA_KP + (16 * ks + 8 * hi) * 2), k1 = *(const LAS bf16x8*)(st + (32 + r) * PA_KP + (16 * ks + 8 * hi) * 2);
                        S0 = __builtin_amdgcn_mfma_f32_32x32x16_bf16(k0, qf[ks], ks == 0 ? Z16 : S0, 0, 0, 0);
                        S1 = __builtin_amdgcn_mfma_f32_32x32x16_bf16(k1, qf[ks], ks == 0 ? Z16 : S1, 0, 0, 0);
                    }
                    const bool diag = (64 * j + 63 > Q0 + 32 * w);
#pragma unroll
                    for (int e = 0; e < 16; ++e) { S0[e] = __builtin_amdgcn_exp2f(S0[e]); S1[e] = __builtin_amdgcn_exp2f(S1[e]); }
                    if (diag) {
                        asm volatile("; causal mask on a diagonal tile" ::: "memory");
#pragma unroll
                        for (int e = 0; e < 16; ++e) { const int kv = 64 * j + (e & 3) + 8 * (e >> 2) + 4 * hi;
                            S0[e] = (kv <= q_glob) ? S0[e] : 0.f; S1[e] = (kv + 32 <= q_glob) ? S1[e] : 0.f; }
                    }
#pragma unroll
                    for (int e = 0; e < 16; e += 2) lsum2 += (f32x2_t){S0[e], S0[e + 1]} + (f32x2_t){S1[e], S1[e + 1]};
                    const LAS unsigned char* vb = st + PA_KB + (4 * hi + ((lane & 15) >> 2)) * PA_VP + (16 * ((lane >> 4) & 1) + 4 * (lane & 3)) * 2;
#pragma unroll
                    for (int u = 0; u < 2; ++u)
#pragma unroll
                        for (int s2 = 0; s2 < 2; ++s2) {
                            bf16x8 pa;
                            if (u == 0) pa = pack8((f32x4){S0[8 * s2], S0[8 * s2 + 1], S0[8 * s2 + 2], S0[8 * s2 + 3]}, (f32x4){S0[8 * s2 + 4], S0[8 * s2 + 5], S0[8 * s2 + 6], S0[8 * s2 + 7]});
                            else        pa = pack8((f32x4){S1[8 * s2], S1[8 * s2 + 1], S1[8 * s2 + 2], S1[8 * s2 + 3]}, (f32x4){S1[8 * s2 + 4], S1[8 * s2 + 5], S1[8 * s2 + 6], S1[8 * s2 + 7]});
                            const int kvo = (32 * u + 16 * s2) * PA_VP;
                            const s16x4 a0 = tr_read(vb + kvo), a1 = tr_read(vb + kvo + 8 * PA_VP), b0 = tr_read(vb + kvo + 64), b1 = tr_read(vb + kvo + 8 * PA_VP + 64);
                            const bf16x8 v0 = (bf16x8){a0[0], a0[1], a0[2], a0[3], a1[0], a1[1], a1[2], a1[3]}, v1 = (bf16x8){b0[0], b0[1], b0[2], b0[3], b1[0], b1[1], b1[2], b1[3]};
                            O0 = __builtin_amdgcn_mfma_f32_32x32x16_bf16(pa, v0, O0, 0, 0, 0);
                            O1 = __builtin_amdgcn_mfma_f32_32x32x16_bf16(pa, v1, O1, 0, 0, 0);
                        }
                }
                if (j + 1 < NT) { PA_NORMK(); LAS unsigned char* nx = lds + ((j + 1) & 1) * PA_STAGE; *(LAS u32x4*)(nx + lk0) = sk0; *(LAS u32x4*)(nx + lv0) = sv0; if (sp < 4) *(LAS u32x4*)(nx + lk1) = sk1; }
                __syncthreads();
            }
            float lsum = lsum2.x + lsum2.y; lsum += __shfl_xor(lsum, 32);
            if (hi == 0) LS[r] = 1.0f / lsum;
            asm volatile("s_waitcnt lgkmcnt(0)" ::: "memory");
            bf16* op = Ob + (rowbase + Q0 + 32 * w) * AW + h * VD + r;
#pragma unroll
            for (int e = 0; e < 16; ++e) { const int q = (e & 3) + 8 * (e >> 2) + 4 * hi; const float il = LS[q];
                op[(size_t)q * AW] = (bf16)f2bf(O0[e] * il); op[(size_t)q * AW + 32] = (bf16)f2bf(O1[e] * il); }
        }
    }
    __syncthreads();
}


#undef PA_NORMK
constexpr int SM_PITCH = 320;
__device__ __forceinline__ void spatial_mix(LAS unsigned char* lds, const bf16* __restrict__ VN, const bf16* __restrict__ WSB, const float* __restrict__ sgu_bs, const bf16* __restrict__ Ub, bf16* __restrict__ UZ) {
    int tid = threadIdx.x; asm volatile("" : "+v"(tid));
    const int lane = tid & 63, w = __builtin_amdgcn_readfirstlane(tid >> 6), r = lane & 31, hi = lane >> 5, tt = w >> 1, cp = w & 1;
    for (int u = blockIdx.x; u < (TP / 128) * 4; u += gridDim.x) {
        const int chunk = u >> 2, g = u & 3; const size_t row0 = (size_t)chunk * 128;
        __syncthreads();
#pragma unroll
        for (int i = 0; i < 4; ++i) { const int pidx = tid + 512 * i, row = pidx >> 4, c16 = pidx & 15;
            *(LAS u32x4*)(lds + row * SM_PITCH + c16 * 16) = *(const u32x4*)(VN + (row0 + row) * AW + g * 128 + c16 * 8); }
        __syncthreads();
        f32x16 D0, D1;
#pragma unroll
        for (int e = 0; e < 16; ++e) { D0[e] = 0.f; D1[e] = 0.f; }
        const bf16* wa = WSB + ((size_t)g * 128 + 32 * tt + r) * 128 + 8 * hi;
        const LAS unsigned char* vb = lds + (8 * hi + ((lane & 15) >> 2)) * SM_PITCH + (64 * cp + 16 * ((lane >> 4) & 1) + 4 * (lane & 3)) * 2;
        for (int ks = 0; ks < 2 * tt + 2; ++ks) {
            const bf16x8 a = *(const bf16x8*)(wa + 16 * ks);
            const LAS unsigned char* vk = vb + 16 * ks * SM_PITCH;
            const s16x4 x0 = tr_read(vk), x1 = tr_read(vk + 4 * SM_PITCH), y0 = tr_read(vk + 64), y1 = tr_read(vk + 4 * SM_PITCH + 64);
            const bf16x8 v0 = (bf16x8){x0[0], x0[1], x0[2], x0[3], x1[0], x1[1], x1[2], x1[3]}, v1 = (bf16x8){y0[0], y0[1], y0[2], y0[3], y1[0], y1[1], y1[2], y1[3]};
            D0 = __builtin_amdgcn_mfma_f32_32x32x16_bf16(a, v0, D0, 0, 0, 0);
            D1 = __builtin_amdgcn_mfma_f32_32x32x16_bf16(a, v1, D1, 0, 0, 0);
        }
#pragma unroll
        for (int e = 0; e < 16; ++e) {
            const int t = 32 * tt + (e & 3) + 8 * (e >> 2) + 4 * hi; const float bias = sgu_bs[g * 128 + t];
            const size_t o = (row0 + t) * AW + g * 128 + 64 * cp + r;
            UZ[o] = (bf16)f2bf(bf2f(Ub[o]) * (D0[e] + bias)); UZ[o + 32] = (bf16)f2bf(bf2f(Ub[o + 32]) * (D1[e] + bias));
        }
    }
    __syncthreads();
}


template <class Q> __device__ __forceinline__ void skgemm(LAS unsigned char* lds, const bf16* __restrict__ A, const bf16* __restrict__ Bt, int row0, int K, const Q& q) {
    int tid = threadIdx.x; asm volatile("" : "+v"(tid));
    const int lane = tid & 63, w = __builtin_amdgcn_readfirstlane(tid >> 6), fr = lane & 15, fq = lane >> 4;
    const int kw = K >> 3, k0 = w * kw;
    for (int tile = blockIdx.x; tile < 256; tile += gridDim.x) {
        const int tm = tile >> 4, tn = tile & 15;
        f32x4 acc[4][4];
#pragma unroll
        for (int i = 0; i < 4; ++i)
#pragma unroll
            for (int j = 0; j < 4; ++j) acc[i][j] = (f32x4){0.f, 0.f, 0.f, 0.f};
        const bf16* ap = A + (size_t)(row0 + 64 * tm + fr) * K + k0;
        const bf16* bp = Bt + (size_t)(64 * tn + fr) * K + k0;
        const int NS = kw >> 5, NP2 = 2 * (NS >> 1);
#define SK_OFF(s_) (((s_) < NP2) ? (((s_) >> 1) * 64 + 16 * fq + ((s_) & 1) * 8) : ((s_) * 32 + 8 * fq))
        bf16x8 a[4], b[4];
        { const int o0 = SK_OFF(0);
#pragma unroll
        for (int i = 0; i < 4; ++i) { a[i] = *(const bf16x8*)(ap + (size_t)16 * i * K + o0); b[i] = *(const bf16x8*)(bp + (size_t)16 * i * K + o0); } }
        for (int st = 0; st < NS; ++st) {
            bf16x8 an[4], bn[4];
            const int sn = (st + 1 < NS) ? st + 1 : st; const int on = SK_OFF(sn);
#pragma unroll
            for (int i = 0; i < 4; ++i) { an[i] = *(const bf16x8*)(ap + (size_t)16 * i * K + on); bn[i] = *(const bf16x8*)(bp + (size_t)16 * i * K + on); }
#pragma unroll
            for (int i = 0; i < 4; ++i)
#pragma unroll
                for (int j = 0; j < 4; ++j) acc[i][j] = __builtin_amdgcn_mfma_f32_16x16x32_bf16(b[j], a[i], acc[i][j], 0, 0, 0);
#pragma unroll
            for (int i = 0; i < 4; ++i) { a[i] = an[i]; b[i] = bn[i]; }
        }
#undef SK_OFF
        __syncthreads();
        LAS float* P = (LAS float*)lds + w * (64 * 68);
#pragma unroll
        for (int i = 0; i < 4; ++i)
#pragma unroll
            for (int j = 0; j < 4; ++j) *(LAS f32x4*)(P + (16 * i + fr) * 68 + 16 * j + 4 * fq) = acc[i][j];
        __syncthreads();
#pragma unroll
        for (int i2 = 0; i2 < 2; ++i2) {
            const int qd = lane + 64 * i2, rl = 8 * w + (qd >> 4), c4 = (qd & 15) * 4;
            f32x4 sum = (f32x4){0.f, 0.f, 0.f, 0.f};
#pragma unroll
            for (int pp = 0; pp < 8; ++pp) sum += *(const LAS f32x4*)((const LAS float*)lds + pp * (64 * 68) + rl * 68 + c4);
            const int row = row0 + 64 * tm + rl;
            float ss = q.quad(row, 64 * tn + c4, sum, q.rowinit(row, 0));
            if constexpr (Q::NEED_SS) { ss = sum16(ss); if ((lane & 15) == 0) q.rowsum(row, ss); }
        }
    }
    __syncthreads();
}
template <class Q> __device__ __forceinline__ void gemm_narrow(LAS unsigned char* lds, const bf16* A, const bf16* Bt, int K, const Q& q) {
    gemm8<false>(lds, A, Bt, TP, DM, K, q);
    skgemm(lds, A, Bt, TP, K, q);
}

template <int MODE> __device__ __forceinline__ int cmap(int n) {
    if (MODE == 0) return n;
    if (MODE == 1) { const int p = n >> 8, j = n & 255; return j < 128 ? 128 * p + j : DFF + 128 * p + (j - 128); }
    if (n < 1024) return n;
    if (n < 1280) return 1408 + (n - 1024);
    if (n < 1664) return 1024 + (n - 1280);
    if (n < 1696) return n;
    if (n < 1792) return -1;
    return 1696 + (n - 1792);
}
template <int MODE> __device__ __forceinline__ void conv_w(const float* __restrict__ src, int K, int Nsrc, bf16* __restrict__ dst, int Ndst, const float* __restrict__ gain, long gt, long ngt) {
    const long total = (long)K * Ndst;
    for (long i = gt; i < total; i += ngt) {
        const int k = (int)(i / Ndst), n = (int)(i % Ndst);
        const int c = cmap<MODE>(n);
        float v = 0.f;
        if (c >= 0) { v = src[(size_t)k * Nsrc + c]; if (gain) v *= gain[k]; }
        dst[(size_t)n * K + k] = (bf16)f2bf(v);
    }
}


template <int MODE> __device__ __forceinline__ void conv_wt(const float* __restrict__ src, int K, int Nsrc, bf16* __restrict__ dst, int Ndst, const float* __restrict__ gain, LAS float* scr, int gw, int ngw, int lane) {
    const int nblk = Ndst / 32, nitems = (K / 64) * nblk;
    for (int it = gw; it < nitems; it += ngw) {
        const int kb = it / nblk, nb = it - kb * nblk, k0 = 64 * kb, n0 = 32 * nb;
        const int c0 = cmap<MODE>(n0);
        f32x4 v[8]; float gv[8];
#pragma unroll
        for (int i = 0; i < 8; ++i) { const int kk = 8 * i + (lane >> 3);
            v[i] = (c0 >= 0) ? *(const f32x4*)(src + (size_t)(k0 + kk) * Nsrc + c0 + 4 * (lane & 7)) : (f32x4){0.f, 0.f, 0.f, 0.f};
            gv[i] = gain ? gain[k0 + kk] : 1.0f; }
#pragma unroll
        for (int i = 0; i < 8; ++i) { const int kk = 8 * i + (lane >> 3); LAS float* sp = scr + kk * 33 + 4 * (lane & 7);
            sp[0] = v[i][0] * gv[i]; sp[1] = v[i][1] * gv[i]; sp[2] = v[i][2] * gv[i]; sp[3] = v[i][3] * gv[i]; }
        asm volatile("s_waitcnt lgkmcnt(0)" ::: "memory");
        const int c = lane & 7;
#pragma unroll
        for (int j = 0; j < 4; ++j) { const int n = (lane >> 3) + 8 * j; const LAS float* sp = scr + (8 * c) * 33 + n;
            u32x4 o; o.x = pk2(sp[0 * 33], sp[1 * 33]); o.y = pk2(sp[2 * 33], sp[3 * 33]); o.z = pk2(sp[4 * 33], sp[5 * 33]); o.w = pk2(sp[6 * 33], sp[7 * 33]);
            *(u32x4*)(dst + (size_t)(n0 + n) * K + k0 + 8 * c) = o; }
        asm volatile("s_waitcnt lgkmcnt(0)" ::: "memory");
    }
}

__device__ __forceinline__ void rope_cs_calc(int pos, int i, float& c, float& s) {
    const double inv = exp2(-(double)i * (13.287712379549449 / 16.0));
    const double ang = (double)((float)pos * (float)inv);
    c = (float)cos(ang); s = (float)sin(ang);
}
constexpr int NROPE = SEQ + DECS;
__device__ __forceinline__ int tok_pos(int r) { return r < TP ? (r & (SEQ - 1)) : PAST + ((r - TP) & (DECS - 1)); }
__device__ __forceinline__ int rope_row(int r) { return r < TP ? (r & (SEQ - 1)) : SEQ + ((r - TP) & (DECS - 1)); }

__global__ void __launch_bounds__(NTHREADS, 2) __attribute__((target("no-packed-fp32-ops"))) fwd(Args a) {
    extern __shared__ __attribute__((aligned(16))) unsigned char lds[];
#define PHASE_IDS() int tid = threadIdx.x; asm volatile("" : "+v"(tid)); const int lane = tid & 63, wave = __builtin_amdgcn_readfirstlane(tid >> 6); \
    const int gw = blockIdx.x * NWAVES + wave, ngw = gridDim.x * NWAVES; const long gt = (long)blockIdx.x * NTHREADS + tid, ngt = (long)gridDim.x * NTHREADS; (void)lane; (void)gw; (void)ngw; (void)gt; (void)ngt
    typedef const __attribute__((address_space(4))) Args* ArgsCP;
    ArgsCP AP = (ArgsCP)__builtin_amdgcn_kernarg_segment_ptr();
#define RELOAD_ARGS() asm volatile("" : "+s"(AP))
    volatile LAS unsigned* MISC = (volatile LAS unsigned*)((LAS unsigned char*)lds + MISC_OFF);
    if (threadIdx.x < 32) MISC[threadIdx.x] = 0u;
    __syncthreads();
    XcdBarrier bar = xcd_barrier_post((unsigned*)(AP->ws + WS_CTL) + CTL_BAR_WORD, MISC + 8);
#define GRID_BAR() do { xcd_barrier(bar); RELOAD_ARGS(); } while (0)
    LAS unsigned char* L = (LAS unsigned char*)lds;

#define x_p (AP->in[0])
#define x_s (AP->in[1])
#define cache_ckv (AP->in[2])
#define cache_kr (AP->in[3])
#define pt (AP->pt)
#define p_p (AP->in[5])
#define p_s (AP->in[6])
#define ffn1_norm (AP->in[7])
#define ffn1_w_in (AP->in[8])
#define ffn1_w_out (AP->in[9])
#define mix_norm (AP->in[10])
#define w_in (AP->in[11])
#define qa_norm (AP->in[12])
#define kva_norm (AP->in[13])
#define w_uq (AP->in[14])
#define w_ukv (AP->in[15])
#define q_norm (AP->in[16])
#define k_norm (AP->in[17])
#define sgu_g (AP->in[18])
#define sgu_b (AP->in[19])
#define sgu_ws (AP->in[20])
#define sgu_bs (AP->in[21])
#define w_a_out (AP->in[22])
#define w_b_out (AP->in[23])
#define w_o (AP->in[24])
#define ffn2_norm (AP->in[25])
#define ffn2_w_in (AP->in[26])
#define ffn2_w_out (AP->in[27])
#define ple_norm (AP->in[28])
#define ple_w_gate (AP->in[29])
#define ple_w_proj (AP->in[30])
#define out (AP->out)
#define W1T ((bf16*)(ws + WS_W1T))
#define W2T ((bf16*)(ws + WS_W2T))
#define WINT ((bf16*)(ws + WS_WINT))
#define WUQT ((bf16*)(ws + WS_WUQT))
#define WUKVT ((bf16*)(ws + WS_WUKVT))
#define WAT ((bf16*)(ws + WS_WAT))
#define WBT ((bf16*)(ws + WS_WBT))
#define WOT ((bf16*)(ws + WS_WOT))
#define W3T ((bf16*)(ws + WS_W3T))
#define W4T ((bf16*)(ws + WS_W4T))
#define WGT ((bf16*)(ws + WS_WGT))
#define WPT ((bf16*)(ws + WS_WPT))
#define WSB ((bf16*)(ws + WS_WSB))
#define XB ((bf16*)(ws + WS_XB))
#define HB ((bf16*)(ws + WS_HB))
#define ACT ((bf16*)(ws + WS_ACT))
#define Ub ((bf16*)(ws + WS_U))
#define Vb ((bf16*)(ws + WS_V))
#define VN ((bf16*)(ws + WS_VN))
#define RAW ((float*)(ws + WS_RAW))
#define SG ((bf16*)(ws + WS_SG))
#define CKV ((bf16*)(ws + WS_CKV))
#define KR ((bf16*)(ws + WS_KR))
#define CQN ((bf16*)(ws + WS_CQN))
#define UZ ((bf16*)(ws + WS_UZ))
#define QRAW ((bf16*)(ws + WS_QRAW))
#define Qn ((bf16*)(ws + WS_Q))
#define KVR ((bf16*)(ws + WS_KVR))
#define KN ((bf16*)(ws + WS_KN))
#define Ob ((bf16*)(ws + WS_O))
#define MXF ((bf16*)(ws + WS_MXF))
#define MX ((bf16*)(ws + WS_MX))
#define PP ((bf16*)(ws + WS_PP))
#define PB ((bf16*)(ws + WS_PB))
#define SSX ((float*)(ws + WS_SSX))
#define OPART ((float*)(ws + WS_KPAST))
#define LPART ((float*)(ws + WS_KPAST + 32 * MiB))
#define SSH1 ((float*)(ws + CTL_SSH1))
#define SSH2 ((float*)(ws + CTL_SSH2))
#define SSH3 ((float*)(ws + CTL_SSH3))
#define Y (out + O_Y)
#define ROPET ((f32x2_t*)(ws + WS_ROPE))
#define GQKT ((float*)(ws + WS_GQK))
#define ws (AP->ws)

    { PHASE_IDS();
    LAS float* scr = (LAS float*)(L + wave * 8448);
    conv_wt<1>(ffn1_w_in, DM, NFF, W1T, NFF, ffn1_norm, scr, (gw + ngw - (0 % ngw)) % ngw, ngw, lane);
    conv_wt<0>(ffn1_w_out, DFF, DM, W2T, DM, nullptr, scr, (gw + ngw - (2816 % ngw)) % ngw, ngw, lane);
    conv_wt<2>(w_in, DM, INC, WINT, INP, mix_norm, scr, (gw + ngw - (4224 % ngw)) % ngw, ngw, lane);
    conv_wt<0>(w_uq, QL, NH * QKH, WUQT, NH * QKH, nullptr, scr, (gw + ngw - (6144 % ngw)) % ngw, ngw, lane);
    conv_wt<0>(w_ukv, KVL, NH * 128, WUKVT, NH * 128, nullptr, scr, (gw + ngw - (6288 % ngw)) % ngw, ngw, lane);
    conv_wt<0>(w_a_out, AW, DM, WAT, DM, nullptr, scr, (gw + ngw - (6416 % ngw)) % ngw, ngw, lane);
    conv_wt<0>(w_b_out, AW, DM, WBT, DM, nullptr, scr, (gw + ngw - (6672 % ngw)) % ngw, ngw, lane);
    conv_wt<0>(w_o, DM, DM, WOT, DM, nullptr, scr, (gw + ngw - (6928 % ngw)) % ngw, ngw, lane);
    conv_wt<1>(ffn2_w_in, DM, NFF, W3T, NFF, ffn2_norm, scr, (gw + ngw - (7440 % ngw)) % ngw, ngw, lane);
    conv_wt<0>(ffn2_w_out, DFF, DM, W4T, DM, nullptr, scr, (gw + ngw - (10256 % ngw)) % ngw, ngw, lane);
    conv_wt<0>(ple_w_gate, DM, DM, WGT, DM, ple_norm, scr, (gw + ngw - (11664 % ngw)) % ngw, ngw, lane);
    conv_wt<0>(ple_w_proj, PLE, DM, WPT, DM, nullptr, scr, (gw + ngw - (12176 % ngw)) % ngw, ngw, lane);
    if (gt < QKH) GQKT[gt] = q_norm[gt] * k_norm[gt];
    for (int i = (int)gt; i < NROPE * 16; i += (int)ngt) { const int row = i >> 4; float c, s_; rope_cs_calc(row < SEQ ? row : PAST + (row - SEQ), i & 15, c, s_); ROPET[i] = (f32x2_t){c, s_}; }
    for (int i = (int)gt; i < 4 * 128 * 128; i += (int)ngt) WSB[i] = ((i & 127) <= ((i >> 7) & 127)) ? (bf16)f2bf(sgu_ws[i]) : (bf16)0;
#pragma unroll 2
    for (int r = gw; r < T; r += ngw) {
        const float* xr = (r < TP) ? x_p + (size_t)r * DM : x_s + (size_t)(r - TP) * DM;
        float s = 0.f;
#pragma unroll
        for (int j = 0; j < 4; ++j) { const f32x4 v = *(const f32x4*)(xr + 256 * j + 4 * lane); s += (v[0] * v[0] + v[1] * v[1]) + (v[2] * v[2] + v[3] * v[3]);
            st_bf4(XB + (size_t)r * DM + 256 * j + 4 * lane, v[0], v[1], v[2], v[3]); }
        s = wave_sum(s); if (lane == 0) SSX[r] = s;
        const float* pr = (r < TP) ? p_p + (size_t)r * PLE : p_s + (size_t)(r - TP) * PLE;
        const f32x4 pv = *(const f32x4*)(pr + 4 * lane); st_bf4(PB + (size_t)r * PLE + 4 * lane, pv[0], pv[1], pv[2], pv[3]);
    }
    }
    GRID_BAR();

    { EpiSwiglu E{ACT, L}; gemm8s<true>(L, XB, W1T, T, NFF, DM, E, SSX); }
    GRID_BAR();
    { EpiResid E{XB, HB, SSH1, 0.5f}; gemm_narrow(L, ACT, W2T, DFF, E); }
    GRID_BAR();
    { PHASE_IDS();
    { EpiIn E{Ub, Vb, RAW, SG, L}; gemm8s<false>(L, HB, WINT, T, INP, DM, E, SSH1); }
    { EpiBf E{PP, DM}; gemm_narrow(L, PB, WPT, PLE, E); }
    }
    GRID_BAR();

    { PHASE_IDS();
    for (int r = gw; r < T; r += ngw) {
        const float* raw = RAW + (size_t)r * 768;
        {
            const f32x4 v = *(const f32x4*)(raw + 4 * lane);
            const float ss = wave_sum((v[0] * v[0] + v[1] * v[1]) + (v[2] * v[2] + v[3] * v[3]));
            const float rinv = rsqrtf(ss * (1.0f / KVL) + EPS);
            const f32x4 g = *(const f32x4*)(kva_norm + 4 * lane);
            const f32x4 c = v * rinv * g;
            float* o = (r < TP) ? out + O_CKVP + (size_t)r * KVL : out + O_CKVS + (size_t)(r - TP) * KVL;
            *(f32x4*)(o + 4 * lane) = c;
            st_bf4(CKV + (size_t)r * KVL + 4 * lane, c[0], c[1], c[2], c[3]);
        }
        {
            if (lane < 16) {
                const float x1 = raw[640 + lane], x2 = raw[656 + lane]; const f32x2_t cs = ROPET[rope_row(r) * 16 + lane]; const float c = cs.x, s = cs.y;
                const float o1 = x1 * c - x2 * s, o2 = x1 * s + x2 * c;
                float* o = (r < TP) ? out + O_KRP + (size_t)r * ROPE : out + O_KRS + (size_t)(r - TP) * ROPE;
                o[lane] = o1; o[16 + lane] = o2;
                KR[(size_t)r * ROPE + lane] = (bf16)f2bf(o1); KR[(size_t)r * ROPE + 16 + lane] = (bf16)f2bf(o2);
            }
        }
        {
            float v[6]; float ss = 0.f;
#pragma unroll
            for (int e = 0; e < 6; ++e) { v[e] = raw[256 + 6 * lane + e]; ss += v[e] * v[e]; }
            ss = wave_sum(ss); const float rinv = rsqrtf(ss * (1.0f / QL) + EPS);
#pragma unroll
            for (int e = 0; e < 6; ++e) CQN[(size_t)r * QL + 6 * lane + e] = (bf16)f2bf(v[e] * rinv * qa_norm[6 * lane + e]);
        }
        {
            const u32x4 w = *(const u32x4*)(Vb + (size_t)r * AW + 8 * lane); float v[8]; unpack8(w, v);
            float s = 0.f;
#pragma unroll
            for (int e = 0; e < 8; ++e) s += v[e];
            const float mean = wave_sum(s) * (1.0f / AW); float q = 0.f;
#pragma unroll
            for (int e = 0; e < 8; ++e) { v[e] -= mean; q += v[e] * v[e]; }
            const float rstd = rsqrtf(wave_sum(q) * (1.0f / AW) + EPS);
#pragma unroll
            for (int e = 0; e < 8; ++e) v[e] = v[e] * rstd * sgu_g[8 * lane + e] + sgu_b[8 * lane + e];
            u32x4 o; o.x = pk2(v[0], v[1]); o.y = pk2(v[2], v[3]); o.z = pk2(v[4], v[5]); o.w = pk2(v[6], v[7]);
            *(u32x4*)(VN + (size_t)r * AW + 8 * lane) = o;
            if (r >= TP) { float* o32 = out + O_VNS + (size_t)(r - TP) * AW + 8 * lane;
                *(f32x4*)o32 = (f32x4){v[0], v[1], v[2], v[3]}; *(f32x4*)(o32 + 4) = (f32x4){v[4], v[5], v[6], v[7]}; }
        }
    }
    }
    GRID_BAR();

    { PHASE_IDS();
    for (int r = TP + gw; r < T; r += ngw) {
        const int tc = (r < TP) ? (r & 127) : ((r - TP) & 7); const int start = r - tc; const int g = lane >> 4;
        float z[8];
#pragma unroll
        for (int e = 0; e < 8; ++e) z[e] = 0.f;
        const float* wrow = sgu_ws + ((size_t)g * 128 + tc) * 128;
        for (int s = 0; s <= tc; ++s) {
            const float w = wrow[s]; const u32x4 vw = *(const u32x4*)(VN + (size_t)(start + s) * AW + 8 * lane); float v[8]; unpack8(vw, v);
#pragma unroll
            for (int e = 0; e < 8; ++e) z[e] += w * v[e];
        }
        const float bsv = sgu_bs[g * 128 + tc];
        const u32x4 uw = *(const u32x4*)(Ub + (size_t)r * AW + 8 * lane); float u[8]; unpack8(uw, u);
#pragma unroll
        for (int e = 0; e < 8; ++e) z[e] = (z[e] + bsv) * u[e];
        u32x4 o; o.x = pk2(z[0], z[1]); o.y = pk2(z[2], z[3]); o.z = pk2(z[4], z[5]); o.w = pk2(z[6], z[7]);
        *(u32x4*)(UZ + (size_t)r * AW + 8 * lane) = o;
    }
    }
    spatial_mix(L, VN, WSB, sgu_bs, Ub, UZ);
    {
    { EpiBf E{QRAW, NH * QKH}; gemm8<false>(L, CQN, WUQT, T, NH * QKH, QL, E); }
    { EpiBf E{KVR, 1024}; gemm_narrow(L, CKV, WUKVT, KVL, E); }
    }
    GRID_BAR();

    prompt_attn(L, QRAW, KVR, KR, ROPET, GQKT, Ob);
    { DecodeArgs D{cache_ckv, cache_kr, pt, QRAW, ROPET, GQKT, WUKVT, out + O_CKVS, out + O_KRS, (const float*)(ws + CTL_ZEROS), OPART, LPART}; decode_attn(L, D); }
    GRID_BAR();

    decode_combine(L, OPART, LPART, WUKVT, Ob);
    { EpiGateA E{MXF, SG}; gemm_narrow(L, UZ, WAT, AW, E); }
    GRID_BAR();
    { EpiGateB E{MXF, SG, MX}; gemm_narrow(L, Ob, WBT, AW, E); }
    GRID_BAR();
    { EpiResid E{HB, HB, SSH2, 1.0f}; gemm_narrow(L, MX, WOT, DM, E); }
    GRID_BAR();
    { EpiSwiglu E{ACT, L}; gemm8s<true>(L, HB, W3T, T, NFF, DM, E, SSH2); }
    GRID_BAR();
    { EpiResid E{HB, HB, SSH3, 0.5f}; gemm_narrow(L, ACT, W4T, DFF, E); }
    GRID_BAR();
    { EpiPleT<true> E{Y, HB, PP, SSH3, L}; gemm8s<false>(L, HB, WGT, TP, DM, DM, E, SSH3); }
    { EpiPleT<false> E{Y, HB, PP, SSH3, L}; skgemm(L, HB, WGT, TP, DM, E); }
}

#undef x_p
#undef x_s
#undef cache_ckv
#undef cache_kr
#undef pt
#undef p_p
#undef p_s
#undef ffn1_norm
#undef ffn1_w_in
#undef ffn1_w_out
#undef mix_norm
#undef w_in
#undef qa_norm
#undef kva_norm
#undef w_uq
#undef w_ukv
#undef q_norm
#undef k_norm
#undef sgu_g
#undef sgu_b
#undef sgu_ws
#undef sgu_bs
#undef w_a_out
#undef w_b_out
#undef w_o
#undef ffn2_norm
#undef ffn2_w_in
#undef ffn2_w_out
#undef ple_norm
#undef ple_w_gate
#undef ple_w_proj
#undef out
#undef W1T
#undef W2T
#undef WINT
#undef WUQT
#undef WUKVT
#undef WAT
#undef WBT
#undef WOT
#undef W3T
#undef W4T
#undef WGT
#undef WPT
#undef WSB
#undef XB
#undef HB
#undef ACT
#undef Ub
#undef Vb
#undef VN
#undef RAW
#undef SG
#undef CKV
#undef KR
#undef CQN
#undef UZ
#undef QRAW
#undef Qn
#undef KVR
#undef KN
#undef Ob
#undef MXF
#undef MX
#undef PP
#undef PB
#undef SSX
#undef OPART
#undef LPART
#undef SSH1
#undef SSH2
#undef SSH3
#undef Y
#undef ROPET
#undef GQKT
#undef ws
#undef RELOAD_ARGS
#undef GRID_BAR
#undef PHASE_IDS
extern "C" void kernel_launch(void* const* d_in, const int* in_sizes, int n_in, void* d_out, int out_size, void* d_ws, size_t ws_size, hipStream_t stream) {
    static int grid = 0;
    if (grid == 0) {
        if (n_in != 31 || (size_t)out_size != O_END || ws_size < WS_END) { fprintf(stderr, "kernel_launch: unexpected shapes: n_in %d out %d ws %zu\n", n_in, out_size, ws_size); grid = -1; return; }
        int dev = 0, cus = 0, per_cu = 0;
        if (hipGetDevice(&dev) != hipSuccess || hipDeviceGetAttribute(&cus, hipDeviceAttributeMultiprocessorCount, dev) != hipSuccess) { grid = -1; return; }
        if (hipFuncSetAttribute((const void*)fwd, hipFuncAttributeMaxDynamicSharedMemorySize, LDS_BYTES) != hipSuccess) { fprintf(stderr, "kernel_launch: hipFuncSetAttribute failed\n"); grid = -1; return; }
        if (hipOccupancyMaxActiveBlocksPerMultiprocessor(&per_cu, (const void*)fwd, NTHREADS, LDS_BYTES) != hipSuccess || per_cu < 1) { fprintf(stderr, "kernel_launch: occupancy query says %d\n", per_cu); grid = -1; (void)hipGetLastError(); return; }
        grid = cus;
    }
    if (grid < 0) return;
    (void)hipMemsetAsync((char*)d_ws + WS_CTL, 0, CTL_ZERO_BYTES, stream);
    Args a{};
    for (int i = 0; i < 31; ++i) a.in[i] = (const float*)d_in[i];
    a.pt = (const int*)d_in[4]; a.out = (float*)d_out; a.ws = (unsigned char*)d_ws;
    hipLaunchKernelGGL(fwd, dim3(grid), dim3(NTHREADS), LDS_BYTES, stream, a);
}
```

```cpp
#include <hip/hip_runtime.h>
#include <cstdio>
#include <cstdint>

#define GAS __attribute__((address_space(1)))
#define LAS __attribute__((address_space(3)))
typedef unsigned short bf16;
typedef short bf16x8 __attribute__((ext_vector_type(8)));
typedef float f32x4 __attribute__((ext_vector_type(4)));
typedef unsigned u32x4 __attribute__((ext_vector_type(4)));
typedef unsigned u32x2 __attribute__((ext_vector_type(2)));

constexpr int DM = 1024, TP = 16384, TS = 1024, T = TP + TS, SEQ = 4096, DFF = 2816, NFF = 2 * DFF;
constexpr int AW = 512, QL = 384, KVL = 256, ROPE = 32, NH = 8, QKH = 96, NOPE = 64, VD = 64, PLE = 256;
constexpr int INC = 3744, INP = 3840;
constexpr int PAST = 8192, PAGE = 128, NPAGES = 64, DECB = 128, DECS = 8;
constexpr float EPS = 1e-6f;
constexpr int NWAVES = 8, NTHREADS = 512;

constexpr size_t O_Y = 0, O_CKVP = (size_t)T * DM, O_KRP = O_CKVP + (size_t)TP * KVL, O_CKVS = O_KRP + (size_t)TP * ROPE,
                 O_KRS = O_CKVS + (size_t)TS * KVL, O_VNS = O_KRS + (size_t)TS * ROPE, O_END = O_VNS + (size_t)TS * AW;

constexpr size_t MiB = 1u << 20;
constexpr size_t WS_CTL = 0, CTL_ZERO_BYTES = 1 * MiB;
constexpr size_t CTL_BAR_WORD = 4096;
constexpr size_t CTL_SSH1 = 262144, CTL_SSH2 = CTL_SSH1 + 131072, CTL_SSH3 = CTL_SSH2 + 131072;
constexpr size_t WS_W1T = 2 * MiB, WS_W2T = 14 * MiB, WS_WINT = 20 * MiB, WS_WUQT = 28 * MiB, WS_WUKVT = 29 * MiB, WS_WAT = 30 * MiB,
                 WS_WBT = 31 * MiB, WS_WOT = 32 * MiB, WS_W3T = 34 * MiB, WS_W4T = 46 * MiB, WS_WGT = 52 * MiB, WS_WPT = 54 * MiB, WS_WSB = 55 * MiB, WS_ROPE = 56 * MiB, WS_GQK = 57 * MiB;
constexpr size_t WS_XB = 64 * MiB, WS_HB = 100 * MiB, WS_ACT = 136 * MiB, WS_U = 232 * MiB, WS_V = 250 * MiB, WS_VN = 268 * MiB,
                 WS_RAW = 286 * MiB, WS_SG = 338 * MiB, WS_CKV = 408 * MiB, WS_KR = 418 * MiB, WS_CQN = 420 * MiB, WS_UZ = 434 * MiB,
                 WS_QRAW = 452 * MiB, WS_Q = 478 * MiB, WS_KVR = 504 * MiB, WS_KN = 538 * MiB, WS_O = 564 * MiB, WS_MXF = 582 * MiB,
                 WS_MX = 650 * MiB, WS_PP = 684 * MiB, WS_PB = 752 * MiB, WS_SSX = 762 * MiB, WS_KPAST = 1024 * MiB, WS_END = 3072 * MiB;

constexpr int LDS_BYTES = 163840, MISC_OFF = 155648;

__device__ __forceinline__ unsigned f2bf(float f) { unsigned u = __builtin_bit_cast(unsigned, f); return (u + 0x7fffu + ((u >> 16) & 1u)) >> 16; }
typedef __bf16 bf16x2_t __attribute__((ext_vector_type(2)));
typedef float f32x2_t __attribute__((ext_vector_type(2)));
__device__ __forceinline__ unsigned cvtpk(float lo, float hi) { f32x2_t v = {lo, hi}; bf16x2_t b = __builtin_convertvector(v, bf16x2_t); return __builtin_bit_cast(unsigned, b); }
__device__ __forceinline__ unsigned pk2(float lo, float hi) { return cvtpk(lo, hi); }
__device__ __forceinline__ float bf2f(unsigned b) { return __builtin_bit_cast(float, b << 16); }
__device__ __forceinline__ float bflo(unsigned w) { return __builtin_bit_cast(float, w << 16); }
__device__ __forceinline__ float bfhi(unsigned w) { return __builtin_bit_cast(float, w & 0xffff0000u); }
template <int CTRL> __device__ __forceinline__ float dpp_f(float v) { return __builtin_bit_cast(float, __builtin_amdgcn_update_dpp(0, __builtin_bit_cast(int, v), CTRL, 0xF, 0xF, true)); }
__device__ __forceinline__ float sum8(float v) {
    v += dpp_f<0xB1>(v);
    v += dpp_f<0x4E>(v);
    v += dpp_f<0x141>(v);
    return v;
}
__device__ __forceinline__ float sum16(float v) { v = sum8(v); v += dpp_f<0x140>(v); return v; }
__device__ __forceinline__ float xor32_sum(float v) { float a = v, b = v; asm volatile("s_nop 1\n\tv_permlane32_swap_b32 %0, %1\n\ts_nop 1" : "+v"(a), "+v"(b)); return a + b; }
__device__ __forceinline__ float wave_sum(float v) {
    v = sum16(v);
    v += __shfl_xor(v, 16);
    return xor32_sum(v);
}
__device__ __forceinline__ float sigmoidf_(float x) { return __builtin_amdgcn_rcpf(1.0f + __builtin_amdgcn_exp2f(-1.4426950408889634f * x)); }
__device__ __forceinline__ float gelu_tanh(float x) {
    const float y = 0.7978845608028654f * (x + 0.044715f * x * x * x);
    const float e = __builtin_amdgcn_exp2f(2.8853900817779268f * y);
    const float th = 1.0f - 2.0f * __builtin_amdgcn_rcpf(e + 1.0f);
    return 0.5f * x * (1.0f + th);
}
__device__ __forceinline__ void unpack8(const u32x4 w, float* f) {
    f[0] = bflo(w.x); f[1] = bfhi(w.x); f[2] = bflo(w.y); f[3] = bfhi(w.y); f[4] = bflo(w.z); f[5] = bfhi(w.z); f[6] = bflo(w.w); f[7] = bfhi(w.w);
}

#define XB_TMO      128
#define XB_XCNT(j)  (256  + 64 * (j))
#define XB_XSUB(j)  (1280 + 64 * (j))
#define XB_XGEN(j)  (2304 + 64 * (j))
#define XB_TOP      3328
#define XB_TOPGEN   3392
#define XCD_BAR_WORDS 3456
#define XB_SPIN_CAP (1u << 21)
__device__ __forceinline__ unsigned xb_ld(unsigned* p)              { return __hip_atomic_load(p, __ATOMIC_RELAXED, __HIP_MEMORY_SCOPE_AGENT); }
__device__ __forceinline__ unsigned xb_add(unsigned* p, unsigned v) { return __hip_atomic_fetch_add(p, v, __ATOMIC_RELAXED, __HIP_MEMORY_SCOPE_AGENT); }
__device__ __forceinline__ unsigned xb_xcc_id() { return (unsigned)__builtin_amdgcn_s_getreg((3 << 11) | 20) & 0xFu; }
#define XB_SPIN(cond, bar) do { unsigned _sp = 0; while (cond) { __builtin_amdgcn_s_sleep(1); \
    if ((++_sp & 255u) == 0u) { if (xb_ld(&(bar)[XB_TMO])) break; if (_sp > XB_SPIN_CAP) { atomicAdd(&(bar)[XB_TMO], 1u); break; } } } } while (0)
struct XcdBarrier { unsigned* bar; unsigned x; volatile LAS unsigned* st; };
__device__ __forceinline__ XcdBarrier xcd_barrier_post(unsigned* bar, volatile LAS unsigned* st) {
    XcdBarrier b; b.bar = bar; b.x = xb_xcc_id(); b.st = st;
    if (threadIdx.x == 0) (void)xb_add(&bar[XB_XCNT(b.x)], 1u);
    return b;
}
__device__ __forceinline__ void xcd_barrier_complete(unsigned* bar, unsigned x, unsigned& nloc, unsigned& nx) {
    const unsigned G = gridDim.x * gridDim.y * gridDim.z;
    unsigned sum, cnt, mine, sp = 0u;
    for (;;) {
        sum = 0u; cnt = 0u; mine = 0u;
#pragma unroll
        for (unsigned j = 0; j < 16; ++j) { const unsigned c = xb_ld(&bar[XB_XCNT(j)]); sum += c; cnt += (c > 0u) ? 1u : 0u; mine = (j == x) ? c : mine; }
        if (sum == G) break;
        __builtin_amdgcn_s_sleep(1);
        if ((++sp & 255u) == 0u) { if (xb_ld(&bar[XB_TMO])) break; if (sp > XB_SPIN_CAP) { atomicAdd(&bar[XB_TMO], 1u); break; } }
    }
    nloc = mine > 0u ? mine : 1u; nx = cnt > 0u ? cnt : 1u;
}
__device__ __forceinline__ void xcd_barrier(const XcdBarrier& b) {
    asm volatile("s_waitcnt vmcnt(0)" ::: "memory");
    __syncthreads();
    if (threadIdx.x == 0) {
        unsigned* bar = b.bar;
        __builtin_amdgcn_s_waitcnt(0);
        unsigned nloc = b.st[0], nx = b.st[1];
        if (nloc == 0u) { xcd_barrier_complete(bar, b.x, nloc, nx); b.st[0] = nloc; b.st[1] = nx; }
        const unsigned old = xb_add(&bar[XB_XSUB(b.x)], 1u);
        const unsigned gen = old / nloc;
        if (old + 1u == (gen + 1u) * nloc) {
            __builtin_amdgcn_fence(__ATOMIC_RELEASE, "agent");
            asm volatile("s_waitcnt vmcnt(0)" ::: "memory");
            const unsigned og = xb_add(&bar[XB_TOP], 1u);
            const unsigned tg = og / nx;
            if (og + 1u == (tg + 1u) * nx) xb_add(&bar[XB_TOPGEN], 1u);
            else XB_SPIN(xb_ld(&bar[XB_TOPGEN]) == tg, bar);
            __builtin_amdgcn_fence(__ATOMIC_ACQUIRE, "agent");
            xb_add(&bar[XB_XGEN(b.x)], 1u);
            asm volatile("s_waitcnt vmcnt(0)" ::: "memory");
        } else {
            XB_SPIN(xb_ld(&bar[XB_XGEN(b.x)]) == gen, bar);
            __builtin_amdgcn_fence(__ATOMIC_ACQUIRE, "agent");
            asm volatile("s_waitcnt vmcnt(0)" ::: "memory");
        }
    }
    __syncthreads();
}

struct Args {
    const float* in[31]; const int* pt; float* out; unsigned char* ws;
};

__device__ __forceinline__ void st_bf4(bf16* p, float a, float b, float c, float d) { u32x2 w; w.x = pk2(a, b); w.y = pk2(c, d); *(u32x2*)p = w; }

constexpr int SSL_OFF = 131072;
__device__ __forceinline__ float ssl_rinv(const LAS unsigned char* lds, int row, int buf) { return __builtin_amdgcn_rsqf(*(const LAS float*)(lds + SSL_OFF + (buf << 10) + ((row & 255) << 2)) * (1.0f / DM) + EPS); }
struct EpiSwiglu {
    static constexpr bool NEED_SS = false;
    bf16* ACT; const LAS unsigned char* lds;
    __device__ __forceinline__ float rowinit(int row, int buf) const { return ssl_rinv(lds, row, buf); }
    __device__ __forceinline__ void pair(int row, int pcol, const f32x4& a, const f32x4& b, float rinv) const {
        const float r2 = -1.4426950408889634f * rinv, rr = rinv * rinv;
        const f32x4 t = a * r2; f32x4 e;
#pragma unroll
        for (int i = 0; i < 4; ++i) e[i] = __builtin_amdgcn_exp2f(t[i]);
        const f32x4 d = e + 1.0f; f32x4 sg;
#pragma unroll
        for (int i = 0; i < 4; ++i) sg[i] = __builtin_amdgcn_rcpf(d[i]);
        const f32x4 o = (a * b) * rr * sg;
        st_bf4(ACT + (size_t)row * DFF + pcol, o[0], o[1], o[2], o[3]);
    }
    __device__ __forceinline__ float quad(int, int, const f32x4&, float) const { return 0.f; }
    __device__ __forceinline__ void rowsum(int, float) const {}
};
struct EpiResid {
    static constexpr bool NEED_SS = true;
    __device__ __forceinline__ float rowinit(int row, int buf) const { (void)row; (void)buf; return 0.f; }
    const bf16* base; bf16* HB; float* ssout; float scale;
    __device__ __forceinline__ float quad(int row, int col, const f32x4& v, float rinv) const {
        const u32x2 b = *(const u32x2*)(base + (size_t)row * DM + col);
        const float h0 = bflo(b.x) + v[0] * scale, h1 = bfhi(b.x) + v[1] * scale, h2 = bflo(b.y) + v[2] * scale, h3 = bfhi(b.y) + v[3] * scale;
        st_bf4(HB + (size_t)row * DM + col, h0, h1, h2, h3);
        return (h0 * h0 + h1 * h1) + (h2 * h2 + h3 * h3);
    }
    __device__ __forceinline__ void rowsum(int row, float s) const { atomicAdd(ssout + row, s); }
    __device__ __forceinline__ void pair(int, int, const f32x4&, const f32x4&, float) const {}
};
struct EpiIn {
    static constexpr bool NEED_SS = false; static constexpr int REGIONS = 4;
    __device__ __forceinline__ float rowinit(int row, int buf) const { return ssl_rinv(lds, row, buf); }
    bf16* U; bf16* V; float* RAW; bf16* SG; const LAS unsigned char* lds;
    __device__ __forceinline__ int region(int pn) const { return pn < 2 ? 0 : pn < 4 ? 1 : pn < 7 ? 2 : 3; }
    template <int R> __device__ __forceinline__ float quadr(int row, int col, const f32x4& v, float rinv) const {
        const f32x4 x = v * rinv;
        if (R == 0) st_bf4(U + (size_t)row * AW + col, gelu_tanh(x[0]), gelu_tanh(x[1]), gelu_tanh(x[2]), gelu_tanh(x[3]));
        else if (R == 1) st_bf4(V + (size_t)row * AW + (col - 512), gelu_tanh(x[0]), gelu_tanh(x[1]), gelu_tanh(x[2]), gelu_tanh(x[3]));
        else if (R == 2) *(f32x4*)(RAW + (size_t)row * 768 + (col - 1024)) = x;
        else st_bf4(SG + (size_t)row * 2048 + (col - 1792), sigmoidf_(x[0]), sigmoidf_(x[1]), sigmoidf_(x[2]), sigmoidf_(x[3]));
        return 0.f;
    }
    __device__ __forceinline__ float quad(int row, int col, const f32x4& v, float rinv) const { return quadr<3>(row, col, v, rinv); }
    __device__ __forceinline__ void rowsum(int, float) const {}
    __device__ __forceinline__ void pair(int, int, const f32x4&, const f32x4&, float) const {}
};
struct EpiBf {
    static constexpr bool NEED_SS = false;
    __device__ __forceinline__ float rowinit(int row, int buf) const { (void)row; (void)buf; return 0.f; }
    bf16* O; int ldc;
    __device__ __forceinline__ float quad(int row, int col, const f32x4& v, float rinv) const { st_bf4(O + (size_t)row * ldc + col, v[0], v[1], v[2], v[3]); return 0.f; }
    __device__ __forceinline__ void rowsum(int, float) const {}
    __device__ __forceinline__ void pair(int, int, const f32x4&, const f32x4&, float) const {}
};
struct EpiF32 {
    static constexpr bool NEED_SS = false;
    __device__ __forceinline__ float rowinit(int row, int buf) const { (void)row; (void)buf; return 0.f; }
    float* O; int ldc;
    __device__ __forceinline__ float quad(int row, int col, const f32x4& v, float rinv) const { *(f32x4*)(O + (size_t)row * ldc + col) = v; return 0.f; }
    __device__ __forceinline__ void rowsum(int, float) const {}
    __device__ __forceinline__ void pair(int, int, const f32x4&, const f32x4&, float) const {}
};
struct EpiGateA {
    static constexpr bool NEED_SS = false;
    __device__ __forceinline__ float rowinit(int row, int buf) const { (void)row; (void)buf; return 0.f; }
    bf16* MXF; const bf16* SG;
    __device__ __forceinline__ float quad(int row, int col, const f32x4& v, float rinv) const {
        const u32x2 g = *(const u32x2*)(SG + (size_t)row * 2048 + col);
        st_bf4(MXF + (size_t)row * DM + col, bflo(g.x) * v[0], bfhi(g.x) * v[1], bflo(g.y) * v[2], bfhi(g.y) * v[3]); return 0.f;
    }
    __device__ __forceinline__ void rowsum(int, float) const {}
    __device__ __forceinline__ void pair(int, int, const f32x4&, const f32x4&, float) const {}
};
struct EpiGateB {
    static constexpr bool NEED_SS = false;
    __device__ __forceinline__ float rowinit(int row, int buf) const { (void)row; (void)buf; return 0.f; }
    const bf16* MXF; const bf16* SG; bf16* MX;
    __device__ __forceinline__ float quad(int row, int col, const f32x4& v, float rinv) const {
        const u32x2 g = *(const u32x2*)(SG + (size_t)row * 2048 + 1024 + col);
        const u32x2 m = *(const u32x2*)(MXF + (size_t)row * DM + col);
        st_bf4(MX + (size_t)row * DM + col, bflo(m.x) + bflo(g.x) * v[0], bfhi(m.x) + bfhi(g.x) * v[1], bflo(m.y) + bflo(g.y) * v[2], bfhi(m.y) + bfhi(g.y) * v[3]);
        return 0.f;
    }
    __device__ __forceinline__ void rowsum(int, float) const {}
    __device__ __forceinline__ void pair(int, int, const f32x4&, const f32x4&, float) const {}
};
template <bool SSL> struct EpiPleT {
    static constexpr bool NEED_SS = false;
    __device__ __forceinline__ float rowinit(int row, int buf) const { if constexpr (SSL) return ssl_rinv(lds, row, buf); else return rsqrtf(ss[row] * (1.0f / DM) + EPS); }
    float* Y; const bf16* HB; const bf16* PP; const float* ss; const LAS unsigned char* lds;
    __device__ __forceinline__ float quad(int row, int col, const f32x4& v, float rinv) const {
        const u32x2 hw = *(const u32x2*)(HB + (size_t)row * DM + col); const u32x2 pw = *(const u32x2*)(PP + (size_t)row * DM + col);
        const float h[4] = {bflo(hw.x), bfhi(hw.x), bflo(hw.y), bfhi(hw.y)}; const float p[4] = {bflo(pw.x), bfhi(pw.x), bflo(pw.y), bfhi(pw.y)};
        f32x4 o;
#pragma unroll
        for (int e = 0; e < 4; ++e) o[e] = h[e] + sigmoidf_(v[e] * rinv) * p[e];
        *(f32x4*)(Y + (size_t)row * DM + col) = o; return 0.f;
    }
    __device__ __forceinline__ void rowsum(int, float) const {}
    __device__ __forceinline__ void pair(int, int, const f32x4&, const f32x4&, float) const {}
};

namespace pg8 {
#define PG8_LAS __attribute__((address_space(3)))
typedef unsigned short bf16_t;
typedef short bf16x8 __attribute__((ext_vector_type(8)));
typedef float f32x4 __attribute__((ext_vector_type(4)));
typedef unsigned u32x4 __attribute__((ext_vector_type(4)));
constexpr int BM = 256, BK = 64, HALF = 128, HTB = HALF * BK * 2  , STAGE_BYTES = 8 * HTB, NXCD = 8, WGM = 8;

__host__ __device__ __forceinline__ int lds_byte(int r, int c) { return r * 128 + ((((c >> 3) ^ ((r >> 1) & 7)) & 7) << 4) + (c & 7) * 2; }
__host__ __device__ __forceinline__ void stage_rc(int b, int& R, int& C) { R = b >> 7; C = ((((b >> 4) & 7) ^ ((R >> 1) & 7)) & 7) << 3; }
__host__ __device__ __forceinline__ int perm32(int rho) { const int n = rho >> 4, i = rho & 15; return 8 * (i >> 2) + 4 * n + (i & 3); }

struct Unit { int pm, pn; };
struct Gemm { const bf16_t* A; const bf16_t* Bt; int M, N, K; };

struct StaticOrder {
    int nM, nN, nwg, G, c;
    __host__ __device__ void init(int M, int N, int G_, int c_) { nM = M / BM; nN = N / BM; nwg = nM * nN; G = G_; c = c_; }
    __host__ __device__ bool next(int i, Unit& u) const {
        const long L = (long)i * G + c; if (L >= nwg) return false;
        int wgid = (int)L; { const int q = nwg / NXCD, r = nwg % NXCD, xcd = wgid % NXCD, off = wgid / NXCD; wgid = (xcd < r ? xcd * (q + 1) : r * (q + 1) + (xcd - r) * q) + off; }
        const int nig = WGM * nN, gid = wgid / nig, fm = gid * WGM, gsz = (nM - fm) < WGM ? (nM - fm) : WGM;
        u.pm = fm + ((wgid % nig) % gsz); u.pn = (wgid % nig) / gsz; return true;
    }
    __device__ __forceinline__ void a_ready(const Unit&) const {}
    __device__ __forceinline__ void done(const Unit&) const {}
};


template <class Epi, class Sched, bool ALIGN_EPI = false, bool SP2 = false>
__device__ __forceinline__ void gemm_phase(PG8_LAS unsigned char* lds, const Gemm g, const Sched& S, const Epi& E) {
    int tid_l = threadIdx.x; asm volatile("" : "+v"(tid_l));
    const int tid = tid_l, wid = __builtin_amdgcn_readfirstlane(tid >> 6), lane = tid & 63, wr = wid >> 2, wc = wid & 3, fr = lane & 15, fq = lane >> 4;
    const int K = g.K, nt = K / BK;
    unsigned voffA[2], voffB[2];
#pragma unroll
    for (int i = 0; i < 2; ++i) { int R, C; stage_rc(tid * 16 + i * 8192, R, C); const int Rb = Epi::PERM ? ((R & ~31) + perm32(R & 31)) : R;
        voffA[i] = (unsigned)(R * K + C) * 2u; voffB[i] = (unsigned)(Rb * K + C) * 2u; }
    const size_t kstep = (size_t)(BK * 2);
    const size_t hstep = (size_t)HALF * K * 2;
    const size_t tstep = 2 * hstep;
    const unsigned ldsw = (unsigned)wid * 1024u;
    const int aoff = lds_byte(wr * 64 + fr, fq * 8), boff = lds_byte(wc * 32 + fr, fq * 8);
#define PG8_SA(b, h) (((b) * 2 + (h)) * HTB)
#define PG8_SB(b, h) ((4 + (b) * 2 + (h)) * HTB)
#define PG8_STAGE(bufoff, gbase, voff) do { _Pragma("unroll") for (int _i = 0; _i < 2; ++_i) \
        __builtin_amdgcn_global_load_lds((const unsigned*)((const char*)(gbase) + (voff)[_i]), (PG8_LAS unsigned*)(lds + (bufoff) + ldsw + _i * 8192), 16, 0, 0); } while (0)
#define PG8_LDA(dst, b, h) do { _Pragma("unroll") for (int m = 0; m < 4; ++m) _Pragma("unroll") for (int k = 0; k < 2; ++k) dst[m][k] = *(const PG8_LAS bf16x8*)(lds + PG8_SA(b, h) + (aoff ^ (k * 64)) + m * 2048); } while (0)
#define PG8_LDB(dst, b, h) do { _Pragma("unroll") for (int n = 0; n < 2; ++n) _Pragma("unroll") for (int k = 0; k < 2; ++k) dst[n][k] = *(const PG8_LAS bf16x8*)(lds + PG8_SB(b, h) + (boff ^ (k * 64)) + n * 2048); } while (0)
#define PG8_MMA(ai, bj, At, Bt) do { __builtin_amdgcn_s_setprio(1); _Pragma("unroll") for (int m = 0; m < 4; ++m) _Pragma("unroll") for (int n = 0; n < 2; ++n) _Pragma("unroll") for (int k = 0; k < 2; ++k) \
        acc[ai][bj][m][n] = __builtin_amdgcn_mfma_f32_16x16x32_bf16(Bt[n][k], At[m][k], acc[ai][bj][m][n], 0, 0, 0); __builtin_amdgcn_s_setprio(0); } while (0)
#define PG8_WAIT_V(n) asm volatile("s_waitcnt vmcnt(" #n ")" ::: "memory")
#define PG8_WAIT_L(n) asm volatile("s_waitcnt lgkmcnt(" #n ")" ::: "memory")
#define PG8_BAR __builtin_amdgcn_s_barrier()
#define PG8_SCHED __builtin_amdgcn_sched_barrier(0)
    Unit cur, nxt; int ui = 0;
    if (!S.next(0, cur)) return;
    f32x4 acc[2][2][4][2];
#pragma unroll
    for (int a = 0; a < 2; ++a)
#pragma unroll
        for (int b = 0; b < 2; ++b)
#pragma unroll
            for (int m = 0; m < 4; ++m)
#pragma unroll
                for (int n = 0; n < 2; ++n) acc[a][b][m][n] = (f32x4){0.f, 0.f, 0.f, 0.f};
    bf16x8 At[4][2], B0[2][2], B1[2][2];
    const char* cA = (const char*)g.A + (size_t)cur.pm * tstep; const char* cB = (const char*)g.Bt + (size_t)cur.pn * tstep;
    S.a_ready(cur);
    if constexpr (SP2) {
        PG8_STAGE(PG8_SB(0, 0), cB, voffB); PG8_STAGE(PG8_SB(0, 1), cB + hstep, voffB); PG8_STAGE(PG8_SA(0, 0), cA, voffA); PG8_STAGE(PG8_SA(0, 1), cA + hstep, voffA);
        if (wr == 1) PG8_BAR;
        PG8_WAIT_V(2); PG8_BAR;
        PG8_STAGE(PG8_SB(1, 0), cB + kstep, voffB); PG8_STAGE(PG8_SA(1, 0), cA + kstep, voffA); PG8_STAGE(PG8_SB(1, 1), cB + hstep + kstep, voffB);
        PG8_WAIT_V(6); PG8_BAR;
    } else {
        PG8_STAGE(PG8_SB(0, 0), cB, voffB); PG8_STAGE(PG8_SA(0, 0), cA, voffA); PG8_STAGE(PG8_SB(0, 1), cB + hstep, voffB); PG8_STAGE(PG8_SA(0, 1), cA + hstep, voffA);
        if (wr == 1) PG8_BAR;
        PG8_WAIT_V(4); PG8_BAR;
        PG8_STAGE(PG8_SB(1, 0), cB + kstep, voffB); PG8_STAGE(PG8_SA(1, 0), cA + kstep, voffA); PG8_STAGE(PG8_SB(1, 1), cB + hstep + kstep, voffB);
        PG8_WAIT_V(6); PG8_BAR;
    }
    for (;;) {
        const bool has_next = S.next(ui + 1, nxt);
        const char* nA = has_next ? (const char*)g.A + (size_t)nxt.pm * tstep : cA; const char* nB = has_next ? (const char*)g.Bt + (size_t)nxt.pn * tstep : cB;
        for (int t = 0; t < nt; t += 2) {
            const bool last = (t == nt - 2);
            const char* a1 = cA + (size_t)(t + 1) * kstep;
            const char* a2 = last ? nA : cA + (size_t)(t + 2) * kstep; const char* b2 = last ? nB : cB + (size_t)(t + 2) * kstep;
            const char* a3 = a2 + kstep; const char* b3 = b2 + kstep;
            if (last && has_next) S.a_ready(nxt);
            if constexpr (SP2) {
            PG8_LDB(B0, 0, 0); PG8_LDB(B1, 0, 1); PG8_SCHED; PG8_LDA(At, 0, 0); PG8_STAGE(PG8_SA(1, 1), a1 + hstep, voffA);
            PG8_WAIT_V(8); PG8_WAIT_L(0); PG8_BAR; PG8_MMA(0, 0, At, B0); PG8_MMA(0, 1, At, B1); PG8_BAR; PG8_SCHED;
            PG8_LDA(At, 0, 1); PG8_STAGE(PG8_SB(0, 0), b2, voffB); PG8_STAGE(PG8_SB(0, 1), b2 + hstep, voffB); PG8_STAGE(PG8_SA(0, 0), a2, voffA);
            PG8_WAIT_V(8); PG8_WAIT_L(0); PG8_BAR; PG8_MMA(1, 0, At, B0); PG8_MMA(1, 1, At, B1); PG8_BAR; PG8_SCHED;
            PG8_LDB(B0, 1, 0); PG8_LDB(B1, 1, 1); PG8_SCHED; PG8_LDA(At, 1, 0); PG8_STAGE(PG8_SA(0, 1), a2 + hstep, voffA);
            PG8_WAIT_V(8); PG8_WAIT_L(0); PG8_BAR; PG8_MMA(0, 0, At, B0); PG8_MMA(0, 1, At, B1); PG8_BAR; PG8_SCHED;
            PG8_LDA(At, 1, 1); PG8_STAGE(PG8_SB(1, 0), b3, voffB); PG8_STAGE(PG8_SB(1, 1), b3 + hstep, voffB); PG8_STAGE(PG8_SA(1, 0), a3, voffA);
            PG8_WAIT_V(8); PG8_WAIT_L(0); PG8_BAR; PG8_MMA(1, 0, At, B0); PG8_MMA(1, 1, At, B1); PG8_BAR; PG8_SCHED;
            } else {
            PG8_LDB(B0, 0, 0); PG8_SCHED; PG8_LDA(At, 0, 0); PG8_STAGE(PG8_SA(1, 1), a1 + hstep, voffA);
            PG8_WAIT_L(8); PG8_BAR; PG8_WAIT_L(0); PG8_MMA(0, 0, At, B0); PG8_BAR; PG8_SCHED;
            PG8_LDB(B1, 0, 1); PG8_STAGE(PG8_SB(0, 0), b2, voffB);
            PG8_BAR; PG8_WAIT_L(0); PG8_MMA(0, 1, At, B1); PG8_BAR;
            PG8_LDA(At, 0, 1); PG8_STAGE(PG8_SA(0, 0), a2, voffA);
            PG8_BAR; PG8_WAIT_L(0); PG8_MMA(1, 0, At, B0); PG8_BAR; PG8_SCHED;
            PG8_STAGE(PG8_SB(0, 1), b2 + hstep, voffB);
            PG8_WAIT_V(6); PG8_BAR; PG8_MMA(1, 1, At, B1); PG8_BAR;
            PG8_LDB(B0, 1, 0); PG8_SCHED; PG8_LDA(At, 1, 0); PG8_STAGE(PG8_SA(0, 1), a2 + hstep, voffA);
            PG8_WAIT_L(8); PG8_BAR; PG8_WAIT_L(0); PG8_MMA(0, 0, At, B0); PG8_BAR; PG8_SCHED;
            PG8_LDB(B1, 1, 1); PG8_STAGE(PG8_SB(1, 0), b3, voffB);
            PG8_BAR; PG8_WAIT_L(0); PG8_MMA(0, 1, At, B1); PG8_BAR;
            PG8_LDA(At, 1, 1); PG8_STAGE(PG8_SA(1, 0), a3, voffA);
            PG8_BAR; PG8_WAIT_L(0); PG8_MMA(1, 0, At, B0); PG8_BAR; PG8_SCHED;
            PG8_STAGE(PG8_SB(1, 1), b3 + hstep, voffB);
            PG8_WAIT_V(6); PG8_BAR; PG8_MMA(1, 1, At, B1); PG8_BAR;
            }
        }
        if constexpr (ALIGN_EPI) { if (wr == 0) PG8_BAR; }
        if constexpr (!Epi::AFTER_DRAIN) { E(acc, cur, wr, wc, fr, fq); S.done(cur); }
        if (!has_next) break;
#pragma unroll
        for (int a = 0; a < 2; ++a)
#pragma unroll
            for (int b = 0; b < 2; ++b)
#pragma unroll
                for (int m = 0; m < 4; ++m)
#pragma unroll
                    for (int n = 0; n < 2; ++n) acc[a][b][m][n] = (f32x4){0.f, 0.f, 0.f, 0.f};
        cur = nxt; cA = nA; cB = nB; ++ui;
        if constexpr (ALIGN_EPI) { if (wr == 1) PG8_BAR; }
    }
    PG8_WAIT_V(0);
    if constexpr (!ALIGN_EPI) { if (wr == 0) PG8_BAR; }
    PG8_BAR;
    if constexpr (Epi::AFTER_DRAIN) { E.fused(acc, cur, wr, wc, fr, fq, lds, wid, lane); S.done(cur); }
#undef PG8_SA
#undef PG8_SB
#undef PG8_STAGE
#undef PG8_LDA
#undef PG8_LDB
#undef PG8_MMA
#undef PG8_WAIT_V
#undef PG8_WAIT_L
#undef PG8_BAR
#undef PG8_SCHED
}
}


template <class Q> struct has_regions { template <class T> static char t(decltype(T::REGIONS)*); template <class T> static long t(...); static constexpr bool value = sizeof(t<Q>(nullptr)) == 1; };
template <class Q, bool PAIR> struct EpiAdapt {
    static constexpr bool PERM = false, AFTER_DRAIN = false;
    Q q; mutable int ucount = 0;
    template <int R> __device__ __forceinline__ void run(const pg8::f32x4 (&acc)[2][2][4][2], const pg8::Unit& u, int wr, int wc, int fr, int fq, int sbuf) const {
#pragma unroll
        for (int ai = 0; ai < 2; ++ai)
#pragma unroll
            for (int m = 0; m < 4; ++m) {
                const int row = u.pm * 256 + ai * 128 + wr * 64 + m * 16 + fr; float ss = 0.f; const float rv = q.rowinit(row, sbuf);
                if constexpr (PAIR) {
#pragma unroll
                    for (int n = 0; n < 2; ++n) q.pair(row, u.pn * 128 + wc * 32 + n * 16 + 4 * fq, acc[ai][0][m][n], acc[ai][1][m][n], rv);
                } else {
#pragma unroll
                    for (int bj = 0; bj < 2; ++bj)
#pragma unroll
                        for (int n = 0; n < 2; ++n) {
                            if constexpr (has_regions<Q>::value) ss += q.template quadr<R>(row, u.pn * 256 + bj * 128 + wc * 32 + n * 16 + 4 * fq, acc[ai][bj][m][n], rv);
                            else ss += q.quad(row, u.pn * 256 + bj * 128 + wc * 32 + n * 16 + 4 * fq, acc[ai][bj][m][n], rv);
                        }
                }
                if constexpr (Q::NEED_SS) { ss += __shfl_xor(ss, 16); ss += __shfl_xor(ss, 32); if (fq == 0) q.rowsum(row, ss); }
            }
    }
    __device__ __forceinline__ void operator()(const pg8::f32x4 (&acc)[2][2][4][2], const pg8::Unit& u, int wr, int wc, int fr, int fq) const {
        const int sbuf = ucount & 1; ++ucount;
        if constexpr (has_regions<Q>::value) {
            const int rg = q.region(u.pn);
            if (rg == 0) run<0>(acc, u, wr, wc, fr, fq, sbuf); else if (rg == 1) run<1>(acc, u, wr, wc, fr, fq, sbuf); else if (rg == 2) run<2>(acc, u, wr, wc, fr, fq, sbuf); else run<3>(acc, u, wr, wc, fr, fq, sbuf);
        } else run<0>(acc, u, wr, wc, fr, fq, sbuf);
    }
};
struct SsOrder : pg8::StaticOrder {
    const float* ss; LAS unsigned char* lds; mutable int ucount = 0;
    __device__ __forceinline__ void a_ready(const pg8::Unit& u) const {
        const int sbuf = ucount & 1; ++ucount;
        const int w = __builtin_amdgcn_readfirstlane((int)threadIdx.x >> 6), lane = threadIdx.x & 63;
        if (w < 4) __builtin_amdgcn_global_load_lds((const unsigned*)(ss + u.pm * 256 + w * 64 + lane), (LAS unsigned*)(lds + SSL_OFF + (sbuf << 10) + (w << 8)), 4, 0, 0);
    }
};
template <bool PAIR, class Q> __device__ __forceinline__ void gemm8s(LAS unsigned char* lds, const bf16* A, const bf16* Bt, int M, int N, int K, const Q& q, const float* ss) {
    pg8::Gemm g{A, Bt, M, N, K}; SsOrder S; S.init(M, N, (int)gridDim.x, (int)blockIdx.x); S.ss = ss; S.lds = lds; S.ucount = 0;
    EpiAdapt<Q, PAIR> E{q, 0};
    pg8::gemm_phase<EpiAdapt<Q, PAIR>, SsOrder, true, true>((PG8_LAS unsigned char*)lds, g, S, E);
}
template <bool PAIR, class Q> __device__ __forceinline__ void gemm8(LAS unsigned char* lds, const bf16* A, const bf16* Bt, int M, int N, int K, const Q& q) {
    pg8::Gemm g{A, Bt, M, N, K}; pg8::StaticOrder S; S.init(M, N, (int)gridDim.x, (int)blockIdx.x);
    EpiAdapt<Q, PAIR> E{q, 0};
    pg8::gemm_phase<EpiAdapt<Q, PAIR>, pg8::StaticOrder, true, true>((PG8_LAS unsigned char*)lds, g, S, E);
}


typedef float f32x16 __attribute__((ext_vector_type(16)));
typedef short s16x4 __attribute__((ext_vector_type(4)));
__device__ __forceinline__ s16x4 tr_read(const LAS unsigned char* p) { return __builtin_bit_cast(s16x4, __builtin_amdgcn_ds_read_tr16_b64_v4i16((LAS s16x4*)p)); }
__device__ __forceinline__ bf16x8 pack8(const f32x4 a, const f32x4 b) { u32x4 w; w.x = cvtpk(a[0], a[1]); w.y = cvtpk(a[2], a[3]); w.z = cvtpk(b[0], b[1]); w.w = cvtpk(b[2], b[3]); return __builtin_bit_cast(bf16x8, w); }
constexpr int DA_SLOT = 36864, DA_BT = 18944;
constexpr int DA_L = 0, DA_B = 2 * DA_SLOT, DA_Q = DA_B + 3 * DA_BT, DA_P = DA_Q + 13824, DA_PG = DA_P + 2 * 5120, DA_SY = DA_PG + 128, DA_END = DA_SY + 16;
static_assert(DA_END <= MISC_OFF && DA_BT % 512 == 0 && DA_B % 512 == 0, "decode LDS map");
constexpr size_t CTL_ZEROS = 786432;

struct DecodeArgs { const float* cache_ckv; const float* cache_kr; const int* pt; const bf16* QRAW; const f32x2_t* ROPET_; const float* GQK; const bf16* WUKVT; const float* new_ckv; const float* new_kr; const float* zeros; float* OP; float* LP; };

__device__ __forceinline__ void decode_attn(LAS unsigned char* lds, const DecodeArgs& D) {
    int tid = threadIdx.x; asm volatile("" : "+v"(tid));
    const int w = __builtin_amdgcn_readfirstlane(tid >> 6);
#define lane0 (tid & 63)
    bf16x8 Wf[2][16];
#pragma unroll
    for (int mt = 0; mt < 2; ++mt)
#pragma unroll
        for (int ks = 0; ks < 16; ++ks) Wf[mt][ks] = *(const bf16x8*)(D.WUKVT + (size_t)(w * 128 + 32 * mt + (lane0 & 31)) * KVL + 16 * ks + 8 * (lane0 >> 5));
    LAS unsigned char* Qp = lds + DA_Q + w * 1728;
    LAS int* PG = (LAS int*)(lds + DA_PG);
    for (int i = lane0; i < 96; i += 64) *(LAS bf16*)(Qp + 8 * 192 + i * 2) = (bf16)0;
    for (int unit = blockIdx.x; unit < 2 * DECB; unit += gridDim.x) {
        const int seq = unit >> 1, half = unit & 1, ntiles = __builtin_amdgcn_readfirstlane(128 + half);
        asm volatile("s_waitcnt vmcnt(0) lgkmcnt(0)" ::: "memory"); __builtin_amdgcn_s_barrier();
        {   int tidu = tid; asm volatile("" : "+v"(tidu)); const int lu = tidu & 63;
        if (tidu < 32) PG[tidu] = D.pt[seq * NPAGES + half * 32 + tidu];
        if (tidu == 0) { *(LAS unsigned*)(lds + DA_SY) = 0u; *(LAS unsigned*)(lds + DA_SY + 4) = 0u; }
        unsigned zz = 0u; asm volatile("" : "+v"(zz));
        for (int i = tidu; i < 5120 / 16; i += NTHREADS) *(LAS u32x4*)(lds + DA_P + 5120 + i * 16) = (u32x4){zz, zz, zz, zz};
        for (int i = tidu; i < DA_BT / 16; i += NTHREADS) *(LAS u32x4*)(lds + DA_B + 2 * DA_BT + i * 16) = (u32x4){zz, zz, zz, zz};
        {
            const int t = lu >> 3, j = lu & 7; const size_t qrow = (size_t)(TP + seq * DECS + t) * (NH * QKH) + w * QKH;
            float v[8]; unpack8(*(const u32x4*)(D.QRAW + qrow + 8 * j), v);
            const unsigned w1 = *(const unsigned*)(D.QRAW + qrow + 64 + 2 * j), w2 = *(const unsigned*)(D.QRAW + qrow + 80 + 2 * j);
            const float x1[2] = {bflo(w1), bfhi(w1)}, x2[2] = {bflo(w2), bfhi(w2)}; float o1[2], o2[2];
#pragma unroll
            for (int e = 0; e < 2; ++e) { const f32x2_t cs = D.ROPET_[(SEQ + t) * 16 + 2 * j + e]; o1[e] = x1[e] * cs.x - x2[e] * cs.y; o2[e] = x1[e] * cs.y + x2[e] * cs.x; }
            float ss = (o1[0] * o1[0] + o1[1] * o1[1]) + (o2[0] * o2[0] + o2[1] * o2[1]);
#pragma unroll
            for (int e = 0; e < 8; ++e) ss += v[e] * v[e];
            ss = sum8(ss);
            const float rq = rsqrtf(ss * (1.0f / QKH) + EPS) * (0.10206207261596575f * 1.4426950408889634f);
            LAS bf16* qp = (LAS bf16*)(Qp + t * 192);
#pragma unroll
            for (int e = 0; e < 8; ++e) { const int d = 8 * j + e;
                const int pos = (d & 48) | (((d >> 2) & 1) << 3) | (((d >> 3) & 1) << 2) | (d & 3);
                qp[pos] = (bf16)f2bf(v[e] * rq * D.GQK[d]); }
#pragma unroll
            for (int e = 0; e < 2; ++e) { qp[64 + 2 * j + e] = (bf16)f2bf(o1[e] * rq * D.GQK[64 + 2 * j + e]); qp[80 + 2 * j + e] = (bf16)f2bf(o2[e] * rq * D.GQK[80 + 2 * j + e]); }
        }
        }
        asm volatile("s_waitcnt vmcnt(0) lgkmcnt(0)" ::: "memory"); __builtin_amdgcn_s_barrier();
        unsigned hz_pv0, hz_pv1, hz_cs, hz_ck, hz_x, hz_kr, hz_q;
        {   int lz = lane0; asm volatile("" : "+v"(lz)); const int rr = lz & 31, hh = lz >> 5, i15 = lz & 15;
            const int col = 32 * w + 16 * ((lz >> 4) & 1) + 4 * (i15 & 3), Pc = col >> 3, hf = (col >> 2) & 1;
            const int k0 = 8 * hh + (i15 >> 2), k1 = k0 + 4; const int sg0 = ((k0 & 3) << 2) | ((k0 >> 2) & 3), sg1 = ((k1 & 3) << 2) | ((k1 >> 2) & 3);
            hz_pv0 = k0 * 512 + ((Pc ^ sg0) << 4) + (hf << 3); hz_pv1 = k1 * 512 + ((Pc ^ sg1) << 4) + (hf << 3);
            hz_cs = ((lz >> 1) << 4) | ((lz & 1) << 3);
            {   const int l31 = lz & 31, key = 4 * w + (l31 >> 3), pc = l31 & 7; hz_ck = 16384 + key * 64 + (((pc >> 1) ^ ((key >> 2) & 3)) << 4) + ((pc & 1) << 3); }
            const int sg = ((rr & 3) << 2) | ((rr >> 2) & 3);
            hz_x = rr * 512 + ((hh ^ sg) << 4);
            hz_kr = 16384 + rr * 64 + ((hh ^ ((rr >> 2) & 3)) << 4);
            hz_q = (rr < 8 ? rr : 8) * 192 + hh * 16;
        }
#define DA_ISSUE(ti) do { const int ti_ = (ti); LAS unsigned char* sl_ = lds + DA_L + (ti_ & 1) * DA_SLOT; int lane = lane0; asm volatile("" : "+v"(lane)); \
            const float* cb_; const float* kb_; int nvalid_ = 32; \
            if (ti_ < 128) { const int pg_ = __builtin_amdgcn_readfirstlane(PG[ti_ >> 2]); const size_t ro_ = (size_t)pg_ * PAGE + (ti_ & 3) * 32; cb_ = D.cache_ckv + ro_ * KVL; kb_ = D.cache_kr + ro_ * ROPE; } \
            else { cb_ = D.new_ckv + (size_t)seq * DECS * KVL; kb_ = D.new_kr + (size_t)seq * DECS * ROPE; nvalid_ = DECS; } \
            _Pragma("unroll") for (int c_ = 0; c_ < 4; ++c_) { const int key_ = 4 * w + c_; \
                const float* src_ = (key_ < nvalid_) ? cb_ + (size_t)key_ * KVL + (lane << 2) : D.zeros + (lane << 2); \
                __builtin_amdgcn_global_load_lds((const unsigned*)src_, (LAS unsigned*)(sl_ + key_ * 1024), 16, 0, 0); } \
            { const int l31_ = lane & 31, key_ = 4 * w + (l31_ >> 3); \
              const float* src_ = (key_ < nvalid_) ? kb_ + (size_t)key_ * ROPE + ((l31_ & 7) << 2) : D.zeros + (l31_ << 2); \
              if (lane < 32) __builtin_amdgcn_global_load_lds((const unsigned*)src_, (LAS unsigned*)(sl_ + 32768 + w * 512), 16, 0, 0); } \
        } while (0)
#define DA_ISSUE_PG(ti, pgv_) do { const int ti_ = (ti); LAS unsigned char* sl_ = lds + DA_L + (ti_ & 1) * DA_SLOT; int lane = lane0; asm volatile("" : "+v"(lane)); \
            const float* cb_; const float* kb_; int nvalid_ = 32; \
            if (ti_ < 128) { const int pg_ = __builtin_amdgcn_readfirstlane(pgv_); const size_t ro_ = (size_t)pg_ * PAGE + (ti_ & 3) * 32; cb_ = D.cache_ckv + ro_ * KVL; kb_ = D.cache_kr + ro_ * ROPE; } \
            else { cb_ = D.new_ckv + (size_t)seq * DECS * KVL; kb_ = D.new_kr + (size_t)seq * DECS * ROPE; nvalid_ = DECS; } \
            _Pragma("unroll") for (int c_ = 0; c_ < 4; ++c_) { const int key_ = 4 * w + c_; \
                const float* src_ = (key_ < nvalid_) ? cb_ + (size_t)key_ * KVL + (lane << 2) : D.zeros + (lane << 2); \
                __builtin_amdgcn_global_load_lds((const unsigned*)src_, (LAS unsigned*)(sl_ + key_ * 1024), 16, 0, 0); } \
            { const int l31_ = lane & 31, key_ = 4 * w + (l31_ >> 3); \
              const float* src_ = (key_ < nvalid_) ? kb_ + (size_t)key_ * ROPE + ((l31_ & 7) << 2) : D.zeros + (l31_ << 2); \
              if (lane < 32) __builtin_amdgcn_global_load_lds((const unsigned*)src_, (LAS unsigned*)(sl_ + 32768 + w * 512), 16, 0, 0); } \
        } while (0)
#define DA_CVT_LOAD(ti) do { const int ti_ = (ti); const LAS unsigned char* sl_ = lds + DA_L + (ti_ & 1) * DA_SLOT; int lane = lane0; asm volatile("" : "+v"(lane)); \
            _Pragma("unroll") for (int c_ = 0; c_ < 4; ++c_) cvr[c_] = *(const LAS f32x4*)(sl_ + (4 * w + c_) * 1024 + lane * 16); \
            cvr[4] = *(const LAS f32x4*)(sl_ + 32768 + (4 * w + ((lane & 31) >> 3)) * 128 + (lane & 7) * 16); } while (0)
#define DA_CVT_STORE(bt_) do { \
            _Pragma("unroll") for (int c_ = 0; c_ < 4; ++c_) { const int key_ = 4 * w + c_, sg_ = ((key_ & 3) << 2) | ((key_ >> 2) & 3); u32x2 o_; o_.x = cvtpk(cvr[c_][0], cvr[c_][1]); o_.y = cvtpk(cvr[c_][2], cvr[c_][3]); \
                *(LAS u32x2*)((bt_) + key_ * 512 + (hz_cs ^ (unsigned)(sg_ << 4))) = o_; } \
            { u32x2 o_; o_.x = cvtpk(cvr[4][0], cvr[4][1]); o_.y = cvtpk(cvr[4][2], cvr[4][3]); \
              if (lane0 < 32) *(LAS u32x2*)((bt_) + hz_ck) = o_; \
              const float q_ = sum8((cvr[4][0] * cvr[4][0] + cvr[4][1] * cvr[4][1]) + (cvr[4][2] * cvr[4][2] + cvr[4][3] * cvr[4][3])) + (float)QKH * EPS;     \
              if ((lane0 & 0x27) == 0) *(LAS float*)((bt_) + 18432 + 16 * w + ((lane0 >> 3) << 2)) = q_; } } while (0)
        DA_ISSUE(0); DA_ISSUE(1);
        asm volatile("s_waitcnt vmcnt(5)" ::: "memory");
        { f32x4 cvr[5]; DA_CVT_LOAD(0); DA_CVT_STORE(lds + DA_B); }
        asm volatile("s_waitcnt lgkmcnt(0)" ::: "memory");
        DA_ISSUE(2);
        __builtin_amdgcn_s_barrier(); asm volatile("" ::: "memory");
        f32x16 O0, O1;
#pragma unroll
        for (int e = 0; e < 16; ++e) { O0[e] = 0.f; O1[e] = 0.f; }
        float ls0 = 0.f, ls1 = 0.f, ls2 = 0.f, ls3 = 0.f;
        int bprev = 2 * DA_BT, bcur = 0, bnext = DA_BT;
#define DA_PV_LOAD(bt_) do { const unsigned a0 = (unsigned)(unsigned long)(bt_) + hz_pv0, a1 = (unsigned)(unsigned long)(bt_) + hz_pv1; \
            asm volatile("ds_read_b64_tr_b16 %0, %1" : "=&v"(c00) : "v"(a0)); asm volatile("ds_read_b64_tr_b16 %0, %1" : "=&v"(c01) : "v"(a1)); \
            asm volatile("ds_read_b64_tr_b16 %0, %1 offset:8192" : "=&v"(c10) : "v"(a0)); asm volatile("ds_read_b64_tr_b16 %0, %1 offset:8192" : "=&v"(c11) : "v"(a1)); \
            } while (0)
#define DA_PV_MMA(pb_) do { int lnB = lane0; asm volatile("" : "+v"(lnB)); const int rr = lnB & 31, hh = lnB >> 5; \
            { const bf16x8 cf0 = (bf16x8){c00[0], c00[1], c00[2], c00[3], c01[0], c01[1], c01[2], c01[3]}; \
              const bf16x8 pa0 = *(const LAS bf16x8*)((pb_) + rr * 80 + (8 * hh) * 2), pb0 = *(const LAS bf16x8*)((pb_) + (32 + rr) * 80 + (8 * hh) * 2); \
              O0 = __builtin_amdgcn_mfma_f32_32x32x16_bf16(pa0, cf0, O0, 0, 0, 0); O1 = __builtin_amdgcn_mfma_f32_32x32x16_bf16(pb0, cf0, O1, 0, 0, 0); } \
            { const bf16x8 cf1 = (bf16x8){c10[0], c10[1], c10[2], c10[3], c11[0], c11[1], c11[2], c11[3]}; \
              const bf16x8 pa1 = *(const LAS bf16x8*)((pb_) + rr * 80 + (16 + 8 * hh) * 2), pb1 = *(const LAS bf16x8*)((pb_) + (32 + rr) * 80 + (16 + 8 * hh) * 2); \
              O0 = __builtin_amdgcn_mfma_f32_32x32x16_bf16(pa1, cf1, O0, 0, 0, 0); O1 = __builtin_amdgcn_mfma_f32_32x32x16_bf16(pb1, cf1, O1, 0, 0, 0); } } while (0)
#define DA_XRD(dst_, ks_) asm volatile("ds_read_b128 %0, %1 offset:%2" : "=v"(dst_) : "v"(xb ^ (32u * ((ks_) & 7))), "n"(256 * ((ks_) >> 3)))
#define DA_LRD(dst_, addr_, off_) asm volatile("ds_read_b128 %0, %1 offset:%2" : "=v"(dst_) : "v"((unsigned)(unsigned long)(addr_)), "n"(off_))
#define DA_KS(kk_) (((kk_) >> 1) + 8 * ((kk_) & 1))
#define DA_SPIN(off_, target_) do { unsigned v_; const unsigned sa_ = (unsigned)(unsigned long)(lds + DA_SY + (off_)); \
            do { asm volatile("ds_read_b32 %0, %1\n\ts_waitcnt lgkmcnt(0)" : "=v"(v_) : "v"(sa_) : "memory"); } while ((unsigned)__builtin_amdgcn_readfirstlane((int)v_) < (unsigned)(target_)); } while (0)
#define DA_SIGNAL(off_) do { const unsigned sa_ = (unsigned)(unsigned long)(lds + DA_SY + (off_)), one_ = 1u; if (lane0 == 0) asm volatile("ds_add_u32 %0, %1" :: "v"(sa_), "v"(one_) : "memory"); } while (0)
        for (int ti = 0; ti < ntiles; ++ti) {
            const LAS unsigned char* bt = lds + DA_B + bcur;
            LAS unsigned char* Pb = lds + DA_P + (ti & 1) * 5120;
            LAS unsigned char* bn = lds + DA_B + bnext;
            const unsigned xb = (unsigned)(unsigned long)bt + hz_x;
            bf16x8 bq[4]; f32x4 cvr[5]; s16x4 c00, c01, c10, c11;
            unsigned cs_, la_;
            {   int lz = lane0; asm volatile("" : "+v"(lz)); cs_ = ((lz >> 1) << 4) | ((lz & 1) << 3);
                const unsigned slc = (unsigned)(unsigned long)(lds + DA_L + ((ti + 1) & 1) * DA_SLOT);
                la_ = slc + 4 * w * 1024 + lz * 16; }
            if (ti > 0) DA_SPIN(0, 8 * ti);
            if (ti + 2 < ntiles) asm volatile("s_waitcnt vmcnt(5)" ::: "memory"); else asm volatile("s_waitcnt vmcnt(0)" ::: "memory");
            const int pgv = PG[(ti + 3) >> 2];
            DA_XRD(bq[0], DA_KS(0)); DA_XRD(bq[1], DA_KS(1)); DA_XRD(bq[2], DA_KS(2));
            asm volatile("s_waitcnt lgkmcnt(0)" : "+v"(bq[0]), "+v"(bq[1]), "+v"(bq[2]) :: "memory");
#define DA_CROW(c_) do { const int key_ = 4 * w + (c_), sg_ = ((key_ & 3) << 2) | ((key_ >> 2) & 3); u32x2 o_; o_.x = cvtpk(cvr[c_][0], cvr[c_][1]); o_.y = cvtpk(cvr[c_][2], cvr[c_][3]); \
                *(LAS u32x2*)(bn + key_ * 512 + (cs_ ^ (unsigned)(sg_ << 4))) = o_; } while (0)
#define DA_CVRD(c_) asm volatile("ds_read_b128 %0, %1 offset:%2" : "=v"(cvr[c_]) : "v"(la_), "n"(1024 * (c_)))
#define DA_WAITV(n_, v_) asm volatile("s_waitcnt lgkmcnt(%1)" : "+v"(v_) : "n"(n_))
            f32x16 X0, X1; const f32x16 Z16 = {0.f, 0.f, 0.f, 0.f, 0.f, 0.f, 0.f, 0.f, 0.f, 0.f, 0.f, 0.f, 0.f, 0.f, 0.f, 0.f};
            u32x4 kw0, kw1; bf16x8 qf[3]; float ssk;
            const float* cb_ = nullptr; const float* kb_ = nullptr; int nvalid_ = 32; LAS unsigned char* sl_ = lds + DA_L + ((ti + 3) & 1) * DA_SLOT;
            const bool dma_ = ti + 3 < ntiles;
            __builtin_amdgcn_s_setprio(1);
#pragma unroll
            for (int kk = 0; kk < 16; ++kk) {
                const int ks = DA_KS(kk);
                if (kk + 3 < 16) DA_XRD(bq[(kk + 3) % 4], DA_KS(kk + 3));
                if (kk < 4) DA_CVRD(kk);
                if (kk == 4) { int lz = lane0; asm volatile("" : "+v"(lz)); const unsigned lk_ = (unsigned)(unsigned long)(lds + DA_L + ((ti + 1) & 1) * DA_SLOT) + 32768 + (4 * w + ((lz & 31) >> 3)) * 128 + (lz & 7) * 16;
                    asm volatile("ds_read_b128 %0, %1" : "=v"(cvr[4]) : "v"(lk_)); }
                if (kk == 15) { int lz = lane0; asm volatile("" : "+v"(lz)); asm volatile("ds_read_b32 %0, %1 offset:18432" : "=v"(ssk) : "v"((unsigned)(unsigned long)bt + ((lz & 31) << 2))); }
                if (kk == 3 || kk == 4) DA_WAITV(7, bq[kk % 4]);
                if (kk == 5) DA_WAITV(6, bq[kk % 4]);
                if (kk == 6) DA_WAITV(5, bq[kk % 4]);
                if (kk == 7) DA_WAITV(4, bq[kk % 4]);
                if (kk >= 8 && kk <= 12) DA_WAITV(3, bq[kk % 4]);
                if (kk == 13) DA_WAITV(2, bq[kk % 4]);
                if (kk == 14) DA_WAITV(5, bq[kk % 4]);
                if (kk == 15) asm volatile("s_waitcnt lgkmcnt(1)" : "+v"(bq[kk % 4]), "+v"(c00), "+v"(c01), "+v"(c10), "+v"(c11));
                X0 = __builtin_amdgcn_mfma_f32_32x32x16_bf16(Wf[0][ks], bq[kk % 4], kk == 0 ? Z16 : X0, 0, 0, 0);
                X1 = __builtin_amdgcn_mfma_f32_32x32x16_bf16(Wf[1][ks], bq[kk % 4], kk == 0 ? Z16 : X1, 0, 0, 0);
                if (kk >= 2 && kk <= 4) { DA_WAITV(4, cvr[kk - 2]); DA_CROW(kk - 2); }
                if (kk == 5) { DA_WAITV(3, cvr[3]); DA_CROW(3); }
                if (kk == 6) { DA_WAITV(2, cvr[4]); u32x2 o_; o_.x = cvtpk(cvr[4][0], cvr[4][1]); o_.y = cvtpk(cvr[4][2], cvr[4][3]);
                    {   int lz = lane0; asm volatile("" : "+v"(lz)); const int l31 = lz & 31, key = 4 * w + (l31 >> 3), pc = l31 & 7; const unsigned ck_ = 16384 + key * 64 + (((pc >> 1) ^ ((key >> 2) & 3)) << 4) + ((pc & 1) << 3);
                        if (lz < 32) *(LAS u32x2*)(bn + ck_) = o_; }
                    const float q_ = sum8((cvr[4][0] * cvr[4][0] + cvr[4][1] * cvr[4][1]) + (cvr[4][2] * cvr[4][2] + cvr[4][3] * cvr[4][3])) + (float)QKH * EPS;
                    if ((lane0 & 0x27) == 0) *(LAS float*)(bn + 18432 + 16 * w + ((lane0 >> 3) << 2)) = q_; }
                if (kk == 7 && dma_) { const int ti_ = ti + 3;
                    if (ti_ < 128) { const int pg_ = __builtin_amdgcn_readfirstlane(pgv); const size_t ro_ = (size_t)pg_ * PAGE + (ti_ & 3) * 32; cb_ = D.cache_ckv + ro_ * KVL; kb_ = D.cache_kr + ro_ * ROPE; }
                    else { cb_ = D.new_ckv + (size_t)seq * DECS * KVL; kb_ = D.new_kr + (size_t)seq * DECS * ROPE; nvalid_ = DECS; } }
                if (kk >= 8 && kk <= 11 && dma_) { const int c_ = kk - 8, key_ = 4 * w + c_; int lane = lane0; asm volatile("" : "+v"(lane));
                    const float* src_ = (key_ < nvalid_) ? cb_ + (size_t)key_ * KVL + (lane << 2) : D.zeros + (lane << 2);
                    __builtin_amdgcn_global_load_lds((const unsigned*)src_, (LAS unsigned*)(sl_ + key_ * 1024), 16, 0, 0); }
                if (kk == 12 && dma_) { int lane = lane0; asm volatile("" : "+v"(lane)); const int l31_ = lane & 31, key_ = 4 * w + (l31_ >> 3);
                    const float* src_ = (key_ < nvalid_) ? kb_ + (size_t)key_ * ROPE + ((l31_ & 7) << 2) : D.zeros + (l31_ << 2);
                    if (lane < 32) __builtin_amdgcn_global_load_lds((const unsigned*)src_, (LAS unsigned*)(sl_ + 32768 + w * 512), 16, 0, 0); }
                if (kk == 13) { int lz = lane0; asm volatile("" : "+v"(lz)); const int hh = lz >> 5, i15 = lz & 15, col = 32 * w + 16 * ((lz >> 4) & 1) + 4 * (i15 & 3), Pc = col >> 3, hf = (col >> 2) & 1;
                    const int k0 = 8 * hh + (i15 >> 2), k1 = k0 + 4; const int sg0 = ((k0 & 3) << 2) | ((k0 >> 2) & 3), sg1 = ((k1 & 3) << 2) | ((k1 >> 2) & 3);
                    const unsigned a0 = (unsigned)(unsigned long)(lds + DA_B + bprev) + k0 * 512 + ((Pc ^ sg0) << 4) + (hf << 3), a1 = (unsigned)(unsigned long)(lds + DA_B + bprev) + k1 * 512 + ((Pc ^ sg1) << 4) + (hf << 3);
                    asm volatile("ds_read_b64_tr_b16 %0, %1" : "=&v"(c00) : "v"(a0)); asm volatile("ds_read_b64_tr_b16 %0, %1" : "=&v"(c01) : "v"(a1));
                    asm volatile("ds_read_b64_tr_b16 %0, %1 offset:8192" : "=&v"(c10) : "v"(a0)); asm volatile("ds_read_b64_tr_b16 %0, %1 offset:8192" : "=&v"(c11) : "v"(a1)); }
            }
            __builtin_amdgcn_s_setprio(0);
#undef DA_CROW
#undef DA_CVRD
#undef DA_WAITV
            DA_SIGNAL(0);
            unsigned hq_, hk_; { int lq = lane0; asm volatile("" : "+v"(lq)); const int rr = lq & 31, hh = lq >> 5; hq_ = (rr < 8 ? rr : 8) * 192 + hh * 16; hk_ = 16384 + rr * 64 + ((hh ^ ((rr >> 2) & 3)) << 4); }
            DA_LRD(qf[0], Qp + hq_, 0); DA_LRD(qf[1], Qp + hq_, 64); DA_LRD(qf[2], Qp + hq_, 128); DA_LRD(kw0, bt + hk_, 0);
            f32x2_t ss2 = {0.f, 0.f};
#pragma unroll
            for (int e = 0; e < 16; e += 2) { const f32x2_t a = {X0[e], X0[e + 1]}, b = {X1[e], X1[e + 1]}; ss2 += a * a; ss2 += b * b; }
            float ss = ss2.x + ss2.y;
            asm volatile("s_waitcnt lgkmcnt(4)" : "+v"(ssk));
            ss = xor32_sum(ss) + ssk;
            const float rinv = rsqrtf(ss * (1.0f / QKH));
            f32x16 S;
            {   const bf16x8 xa = pack8((f32x4){X0[0], X0[1], X0[2], X0[3]}, (f32x4){X0[4], X0[5], X0[6], X0[7]});
                const bf16x8 xc = pack8((f32x4){X1[0], X1[1], X1[2], X1[3]}, (f32x4){X1[4], X1[5], X1[6], X1[7]});
                asm volatile("s_waitcnt lgkmcnt(0)" : "+v"(qf[0]), "+v"(qf[1]), "+v"(qf[2]), "+v"(kw0));
                S = __builtin_amdgcn_mfma_f32_32x32x16_bf16(qf[0], xa, Z16, 0, 0, 0);
                S = __builtin_amdgcn_mfma_f32_32x32x16_bf16(qf[1], xc, S, 0, 0, 0);
                S = __builtin_amdgcn_mfma_f32_32x32x16_bf16(qf[2], __builtin_bit_cast(bf16x8, kw0), S, 0, 0, 0); }
            {   bf16x8 qg[3];
                DA_LRD(qg[0], Qp + hq_, 32); DA_LRD(qg[1], Qp + hq_, 96); DA_LRD(qg[2], Qp + hq_, 160); DA_LRD(kw1, bt + (hk_ ^ 32u), 0);
                const bf16x8 xa = pack8((f32x4){X0[8], X0[9], X0[10], X0[11]}, (f32x4){X0[12], X0[13], X0[14], X0[15]});
                const bf16x8 xc = pack8((f32x4){X1[8], X1[9], X1[10], X1[11]}, (f32x4){X1[12], X1[13], X1[14], X1[15]});
                asm volatile("s_waitcnt lgkmcnt(0)" : "+v"(qg[0]), "+v"(qg[1]), "+v"(qg[2]), "+v"(kw1));
                S = __builtin_amdgcn_mfma_f32_32x32x16_bf16(qg[0], xa, S, 0, 0, 0);
                S = __builtin_amdgcn_mfma_f32_32x32x16_bf16(qg[1], xc, S, 0, 0, 0);
                S = __builtin_amdgcn_mfma_f32_32x32x16_bf16(qg[2], __builtin_bit_cast(bf16x8, kw1), S, 0, 0, 0); }
            float p0v = __builtin_amdgcn_exp2f(S[0] * rinv), p1v = __builtin_amdgcn_exp2f(S[1] * rinv), p2v = __builtin_amdgcn_exp2f(S[2] * rinv), p3v = __builtin_amdgcn_exp2f(S[3] * rinv);
            if (ti >= 128) { int lnA = lane0; asm volatile("; causal mask of the new-token tile" : "+v"(lnA)); const int r = lnA & 31, t0 = 4 * (lnA >> 5); p0v = (r <= t0) ? p0v : 0.f; p1v = (r <= t0 + 1) ? p1v : 0.f; p2v = (r <= t0 + 2) ? p2v : 0.f; p3v = (r <= t0 + 3) ? p3v : 0.f; }
            ls0 += p0v; ls1 += p1v; ls2 += p2v; ls3 += p3v;
            if (ti > 0) DA_SPIN(4, 8 * ti);
            {   bf16x8 pa0, pb0, pa1, pb1;
                {   int lnB = lane0; asm volatile("" : "+v"(lnB)); const LAS unsigned char* pp = lds + DA_P + ((ti + 1) & 1) * 5120 + (lnB & 31) * 80 + (lnB >> 5) * 16;
                    DA_LRD(pa0, pp, 0); DA_LRD(pb0, pp, 2560); DA_LRD(pa1, pp, 32); DA_LRD(pb1, pp, 2592); }
                asm volatile("s_waitcnt lgkmcnt(0)" : "+v"(pa0), "+v"(pb0), "+v"(pa1), "+v"(pb1) :: "memory");
                const bf16x8 cf0 = (bf16x8){c00[0], c00[1], c00[2], c00[3], c01[0], c01[1], c01[2], c01[3]};
                O0 = __builtin_amdgcn_mfma_f32_32x32x16_bf16(pa0, cf0, O0, 0, 0, 0); O1 = __builtin_amdgcn_mfma_f32_32x32x16_bf16(pb0, cf0, O1, 0, 0, 0);
                const bf16x8 cf1 = (bf16x8){c10[0], c10[1], c10[2], c10[3], c11[0], c11[1], c11[2], c11[3]};
                O0 = __builtin_amdgcn_mfma_f32_32x32x16_bf16(pa1, cf1, O0, 0, 0, 0); O1 = __builtin_amdgcn_mfma_f32_32x32x16_bf16(pb1, cf1, O1, 0, 0, 0); }
            {   int lnW = lane0; asm volatile("" : "+v"(lnW)); LAS unsigned char* pw = Pb + ((w * 8 + 4 * (lnW >> 5)) * 80 + (lnW & 31) * 2);
                *(LAS bf16*)(pw) = (bf16)(cvtpk(p0v, 0.f) & 0xffffu); *(LAS bf16*)(pw + 80) = (bf16)(cvtpk(p1v, 0.f) & 0xffffu);
                *(LAS bf16*)(pw + 160) = (bf16)(cvtpk(p2v, 0.f) & 0xffffu); *(LAS bf16*)(pw + 240) = (bf16)(cvtpk(p3v, 0.f) & 0xffffu); }
            asm volatile("" ::: "memory");
            DA_SIGNAL(4);
            { const int t_ = bprev; bprev = bcur; bcur = bnext; bnext = t_; }
        }
        DA_SPIN(4, 8 * ntiles);
#undef DA_KS
        {   s16x4 c00, c01, c10, c11;
            {   int lz = lane0; asm volatile("" : "+v"(lz)); const int hh = lz >> 5, i15 = lz & 15, col = 32 * w + 16 * ((lz >> 4) & 1) + 4 * (i15 & 3), Pc = col >> 3, hf = (col >> 2) & 1;
                const int k0 = 8 * hh + (i15 >> 2), k1 = k0 + 4; const int sg0 = ((k0 & 3) << 2) | ((k0 >> 2) & 3), sg1 = ((k1 & 3) << 2) | ((k1 >> 2) & 3);
                const unsigned a0 = (unsigned)(unsigned long)(lds + DA_B + bprev) + k0 * 512 + ((Pc ^ sg0) << 4) + (hf << 3), a1 = (unsigned)(unsigned long)(lds + DA_B + bprev) + k1 * 512 + ((Pc ^ sg1) << 4) + (hf << 3);
                asm volatile("ds_read_b64_tr_b16 %0, %1" : "=&v"(c00) : "v"(a0)); asm volatile("ds_read_b64_tr_b16 %0, %1" : "=&v"(c01) : "v"(a1));
                asm volatile("ds_read_b64_tr_b16 %0, %1 offset:8192" : "=&v"(c10) : "v"(a0)); asm volatile("ds_read_b64_tr_b16 %0, %1 offset:8192" : "=&v"(c11) : "v"(a1)); }
            asm volatile("s_waitcnt lgkmcnt(0)" : "+v"(c00), "+v"(c01), "+v"(c10), "+v"(c11) :: "memory");
            DA_PV_MMA(lds + DA_P + ((ntiles - 1) & 1) * 5120); }
        {   int lnE = lane0, unE = unit; asm volatile("" : "+v"(lnE), "+s"(unE));
            const int r = lnE & 31, hi = lnE >> 5;
            float* op = D.OP + (size_t)unE * 64 * KVL + 32 * w + r;
#pragma unroll
            for (int e = 0; e < 16; ++e) { const int row = (e & 3) + 8 * (e >> 2) + 4 * hi; op[(size_t)row * KVL] = O0[e]; op[(size_t)(32 + row) * KVL] = O1[e]; }
#pragma unroll
            for (int o = 1; o < 32; o <<= 1) { const int pa_ = (lnE ^ o) << 2;
#define DA_SX(v_) __builtin_bit_cast(float, __builtin_amdgcn_ds_bpermute(pa_, __builtin_bit_cast(int, v_)))
                ls0 += DA_SX(ls0); ls1 += DA_SX(ls1); ls2 += DA_SX(ls2); ls3 += DA_SX(ls3); }
#undef DA_SX
            if (r == 0) { float* lp = D.LP + (size_t)unE * 64 + w * 8 + 4 * hi; lp[0] = ls0; lp[1] = ls1; lp[2] = ls2; lp[3] = ls3; }
        }
#undef DA_ISSUE
#undef DA_ISSUE_PG
#undef DA_XRD
#undef DA_LRD
#undef DA_CVT_LOAD
#undef DA_CVT_STORE
#undef DA_PV_LOAD
#undef DA_PV_MMA
#undef DA_SPIN
#undef DA_SIGNAL
    }
    asm volatile("s_waitcnt vmcnt(0) lgkmcnt(0)" ::: "memory"); __builtin_amdgcn_s_barrier();
#undef lane0
}
__device__ __forceinline__ void decode_combine(LAS unsigned char* lds, const float* __restrict__ OP, const float* __restrict__ LP, const bf16* __restrict__ WUKVT, bf16* __restrict__ Ob) {
    int tid = threadIdx.x; asm volatile("" : "+v"(tid));
    const int lane = tid & 63, w = __builtin_amdgcn_readfirstlane(tid >> 6), r = lane & 31, hi = lane >> 5, n = w & 1, kq = w >> 1;
    LAS float* PT = (LAS float*)lds;
    for (int u = blockIdx.x; u < 256; u += gridDim.x) {
        const int h = u & 7, sgp = u >> 3, seq = 4 * sgp + (r >> 3), t = r & 7;
        const size_t ro0 = ((size_t)(2 * seq) * 64 + h * 8 + t), ro1 = ro0 + 64;
        const float il = 1.0f / (LP[ro0] + LP[ro1]);
        f32x16 D;
#pragma unroll
        for (int e = 0; e < 16; ++e) D[e] = 0.f;
        f32x4 x0[4], x1[4], y0[4], y1[4]; bf16x8 bw[4];
#pragma unroll
        for (int q = 0; q < 4; ++q) { const int c = 16 * (4 * kq + q) + 8 * hi;
            x0[q] = *(const f32x4*)(OP + ro0 * KVL + c); x1[q] = *(const f32x4*)(OP + ro0 * KVL + c + 4);
            y0[q] = *(const f32x4*)(OP + ro1 * KVL + c); y1[q] = *(const f32x4*)(OP + ro1 * KVL + c + 4);
            bw[q] = *(const bf16x8*)(WUKVT + (size_t)(h * 128 + 64 + 32 * n + r) * KVL + c); }
#pragma unroll
        for (int q = 0; q < 4; ++q) D = __builtin_amdgcn_mfma_f32_32x32x16_bf16(pack8((x0[q] + y0[q]) * il, (x1[q] + y1[q]) * il), bw[q], D, 0, 0, 0);
        __syncthreads();
#pragma unroll
        for (int e = 0; e < 16; ++e) PT[w * 1024 + ((e & 3) + 8 * (e >> 2) + 4 * hi) * 32 + r] = D[e];
        __syncthreads();
        if (w < 2) {
#pragma unroll
            for (int e = 0; e < 16; ++e) { const int row = (e & 3) + 8 * (e >> 2) + 4 * hi; const int o = row * 32 + r;
                const float v = (PT[w * 1024 + o] + PT[(w + 2) * 1024 + o]) + (PT[(w + 4) * 1024 + o] + PT[(w + 6) * 1024 + o]);
                Ob[(size_t)(TP + (4 * sgp + (row >> 3)) * DECS + (row & 7)) * AW + h * VD + 32 * w + r] = (bf16)f2bf(v); }
        }
    }
    __syncthreads();
}

constexpr int PA_KP = 208, PA_VP = 192, PA_KB = 64 * PA_KP, PA_VB = 64 * PA_VP, PA_STAGE = PA_KB + PA_VB, PA_LS = 2 * PA_STAGE;

__device__ __forceinline__ void prompt_attn(LAS unsigned char* lds, const bf16* __restrict__ QRAW, const bf16* __restrict__ KVR, const bf16* __restrict__ KRb, const f32x2_t* __restrict__ ROPET_, const float* __restrict__ GQK, bf16* __restrict__ Ob) {
    int tid = threadIdx.x; asm volatile("" : "+v"(tid));
    const int lane = tid & 63, w = __builtin_amdgcn_readfirstlane(tid >> 6), r = lane & 31, hi = lane >> 5;
    LAS float* LS = (LAS float*)(lds + PA_LS) + w * 32;
    for (int pi = blockIdx.x; pi < 256; pi += gridDim.x) {
        const int bh = pi >> 3, b = bh >> 3, h = bh & 7;
#pragma unroll 1
        for (int uu = 0; uu < 2; ++uu) {
            const int qb = uu == 0 ? (pi & 7) : 15 - (pi & 7);
            const size_t rowbase = (size_t)b * SEQ; const int Q0 = qb * 256, NT = 4 * (qb + 1);
            const int q_glob = Q0 + 32 * w + r;
            bf16x8 qf[6];
            {   float qv[6][8];
#pragma unroll
                for (int ks = 0; ks < 6; ++ks) unpack8(*(const u32x4*)(QRAW + (rowbase + q_glob) * (NH * QKH) + h * QKH + 16 * ks + 8 * hi), qv[ks]);
                float ss = 0.f;
#pragma unroll
                for (int j = 0; j < 8; ++j) { const f32x2_t cs = ROPET_[q_glob * 16 + 8 * hi + j]; const float x1 = qv[4][j], x2 = qv[5][j]; qv[4][j] = x1 * cs.x - x2 * cs.y; qv[5][j] = x1 * cs.y + x2 * cs.x; }
#pragma unroll
                for (int ks = 0; ks < 6; ++ks)
#pragma unroll
                    for (int j = 0; j < 8; ++j) ss += qv[ks][j] * qv[ks][j];
                ss = xor32_sum(ss);
                const float rq = rsqrtf(ss * (1.0f / QKH) + EPS) * (0.10206207261596575f * 1.4426950408889634f);
#pragma unroll
                for (int ks = 0; ks < 6; ++ks) { const f32x4 g0 = *(const f32x4*)(GQK + 16 * ks + 8 * hi), g1 = *(const f32x4*)(GQK + 16 * ks + 8 * hi + 4);
                    qf[ks] = pack8((f32x4){qv[ks][0], qv[ks][1], qv[ks][2], qv[ks][3]} * g0 * rq, (f32x4){qv[ks][4], qv[ks][5], qv[ks][6], qv[ks][7]} * g1 * rq); }
            }
            const int sp = tid & 7;
            const bf16* gk0 = KVR + (rowbase + (tid >> 3)) * 1024 + h * 128 + sp * 8;
            const bf16* gv0 = gk0 + 64;
            const bf16* gk1 = KRb + (rowbase + (tid >> 3)) * ROPE + (sp & 3) * 8;
            const int lk0 = (tid >> 3) * PA_KP + sp * 16, lv0 = PA_KB + (tid >> 3) * PA_VP + sp * 16, lk1 = (tid >> 3) * PA_KP + 128 + (sp & 3) * 16;
            u32x4 sk0 = *(const u32x4*)gk0, sv0 = *(const u32x4*)gv0, sk1 = *(const u32x4*)gk1;
#define PA_NORMK() do { float f0[8], f1[8]; unpack8(sk0, f0); unpack8(sk1, f1); f32x2_t s2_ = {0.f, 0.f}; \
                _Pragma("unroll") for (int e = 0; e < 8; e += 2) { const f32x2_t a_ = {f0[e], f0[e + 1]}; s2_ += a_ * a_; } \
                if (sp < 4) { _Pragma("unroll") for (int e = 0; e < 8; e += 2) { const f32x2_t a_ = {f1[e], f1[e + 1]}; s2_ += a_ * a_; } } \
                float ss_ = s2_.x + s2_.y; ss_ = sum8(ss_); const float rk_ = rsqrtf(ss_ * (1.0f / QKH) + EPS); \
                sk0.x = cvtpk(f0[0] * rk_, f0[1] * rk_); sk0.y = cvtpk(f0[2] * rk_, f0[3] * rk_); sk0.z = cvtpk(f0[4] * rk_, f0[5] * rk_); sk0.w = cvtpk(f0[6] * rk_, f0[7] * rk_); \
                sk1.x = cvtpk(f1[0] * rk_, f1[1] * rk_); sk1.y = cvtpk(f1[2] * rk_, f1[3] * rk_); sk1.z = cvtpk(f1[4] * rk_, f1[5] * rk_); sk1.w = cvtpk(f1[6] * rk_, f1[7] * rk_); } while (0)
            PA_NORMK();
            __syncthreads();
            *(LAS u32x4*)(lds + lk0) = sk0; *(LAS u32x4*)(lds + lv0) = sv0; if (sp < 4) *(LAS u32x4*)(lds + lk1) = sk1;
            __syncthreads();
            f32x16 O0, O1;
#pragma unroll
            for (int e = 0; e < 16; ++e) { O0[e] = 0.f; O1[e] = 0.f; }
            f32x2_t lsum2 = {0.f, 0.f};
            for (int j = 0; j < NT; ++j) {
                const LAS unsigned char* st = lds + (j & 1) * PA_STAGE;
                if (j + 1 < NT) { const size_t o = (size_t)(j + 1) * 64; sk0 = *(const u32x4*)(gk0 + o * 1024); sv0 = *(const u32x4*)(gv0 + o * 1024); sk1 = *(const u32x4*)(gk1 + o * ROPE); }
                if (64 * j <= Q0 + 32 * w + 31) {
                    f32x16 S0, S1; const f32x16 Z16 = {0.f, 0.f, 0.f, 0.f, 0.f, 0.f, 0.f, 0.f, 0.f, 0.f, 0.f, 0.f, 0.f, 0.f, 0.f, 0.f};
#pragma unroll
                    for (int ks = 0; ks < 6; ++ks) {
                        const bf16x8 k0 = *(const LAS bf16x8*)(st + r * PA_KP + (16 * ks + 8 * hi) * 2), k1 = *(const LAS bf16x8*)(st + (32 + r) * PA_KP + (16 * ks + 8 * hi) * 2);
                        S0 = __builtin_amdgcn_mfma_f32_32x32x16_bf16(k0, qf[ks], ks == 0 ? Z16 : S0, 0, 0, 0);
                        S1 = __builtin_amdgcn_mfma_f32_32x32x16_bf16(k1, qf[ks], ks == 0 ? Z16 : S1, 0, 0, 0);
                    }
                    const bool diag = (64 * j + 63 > Q0 + 32 * w);
#pragma unroll
                    for (int e = 0; e < 16; ++e) { S0[e] = __builtin_amdgcn_exp2f(S0[e]); S1[e] = __builtin_amdgcn_exp2f(S1[e]); }
                    if (diag) {
                        asm volatile("; causal mask on a diagonal tile" ::: "memory");
#pragma unroll
                        for (int e = 0; e < 16; ++e) { const int kv = 64 * j + (e & 3) + 8 * (e >> 2) + 4 * hi;
                            S0[e] = (kv <= q_glob) ? S0[e] : 0.f; S1[e] = (kv + 32 <= q_glob) ? S1[e] : 0.f; }
                    }
#pragma unroll
                    for (int e = 0; e < 16; e += 2) lsum2 += (f32x2_t){S0[e], S0[e + 1]} + (f32x2_t){S1[e], S1[e + 1]};
                    const LAS unsigned char* vb = st + PA_KB + (4 * hi + ((lane & 15) >> 2)) * PA_VP + (16 * ((lane >> 4) & 1) + 4 * (lane & 3)) * 2;
#pragma unroll
                    for (int u = 0; u < 2; ++u)
#pragma unroll
                        for (int s2 = 0; s2 < 2; ++s2) {
                            bf16x8 pa;
                            if (u == 0) pa = pack8((f32x4){S0[8 * s2], S0[8 * s2 + 1], S0[8 * s2 + 2], S0[8 * s2 + 3]}, (f32x4){S0[8 * s2 + 4], S0[8 * s2 + 5], S0[8 * s2 + 6], S0[8 * s2 + 7]});
                            else        pa = pack8((f32x4){S1[8 * s2], S1[8 * s2 + 1], S1[8 * s2 + 2], S1[8 * s2 + 3]}, (f32x4){S1[8 * s2 + 4], S1[8 * s2 + 5], S1[8 * s2 + 6], S1[8 * s2 + 7]});
                            const int kvo = (32 * u + 16 * s2) * PA_VP;
                            const s16x4 a0 = tr_read(vb + kvo), a1 = tr_read(vb + kvo + 8 * PA_VP), b0 = tr_read(vb + kvo + 64), b1 = tr_read(vb + kvo + 8 * PA_VP + 64);
                            const bf16x8 v0 = (bf16x8){a0[0], a0[1], a0[2], a0[3], a1[0], a1[1], a1[2], a1[3]}, v1 = (bf16x8){b0[0], b0[1], b0[2], b0[3], b1[0], b1[1], b1[2], b1[3]};
                            O0 = __builtin_amdgcn_mfma_f32_32x32x16_bf16(pa, v0, O0, 0, 0, 0);
                            O1 = __builtin_amdgcn_mfma_f32_32x32x16_bf16(pa, v1, O1, 0, 0, 0);
                        }
                }
                if (j + 1 < NT) { PA_NORMK(); LAS unsigned char* nx = lds + ((j + 1) & 1) * PA_STAGE; *(LAS u32x4*)(nx + lk0) = sk0; *(LAS u32x4*)(nx + lv0) = sv0; if (sp < 4) *(LAS u32x4*)(nx + lk1) = sk1; }
                __syncthreads();
            }
            float lsum = lsum2.x + lsum2.y; lsum += __shfl_xor(lsum, 32);
            if (hi == 0) LS[r] = 1.0f / lsum;
            asm volatile("s_waitcnt lgkmcnt(0)" ::: "memory");
            bf16* op = Ob + (rowbase + Q0 + 32 * w) * AW + h * VD + r;
#pragma unroll
            for (int e = 0; e < 16; ++e) { const int q = (e & 3) + 8 * (e >> 2) + 4 * hi; const float il = LS[q];
                op[(size_t)q * AW] = (bf16)f2bf(O0[e] * il); op[(size_t)q * AW + 32] = (bf16)f2bf(O1[e] * il); }
        }
    }
    __syncthreads();
}


#undef PA_NORMK
constexpr int SM_PITCH = 320;
__device__ __forceinline__ void spatial_mix(LAS unsigned char* lds, const bf16* __restrict__ VN, const bf16* __restrict__ WSB, const float* __restrict__ sgu_bs, const bf16* __restrict__ Ub, bf16* __restrict__ UZ) {
    int tid = threadIdx.x; asm volatile("" : "+v"(tid));
    const int lane = tid & 63, w = __builtin_amdgcn_readfirstlane(tid >> 6), r = lane & 31, hi = lane >> 5, tt = w >> 1, cp = w & 1;
    for (int u = blockIdx.x; u < (TP / 128) * 4; u += gridDim.x) {
        const int chunk = u >> 2, g = u & 3; const size_t row0 = (size_t)chunk * 128;
        __syncthreads();
#pragma unroll
        for (int i = 0; i < 4; ++i) { const int pidx = tid + 512 * i, row = pidx >> 4, c16 = pidx & 15;
            *(LAS u32x4*)(lds + row * SM_PITCH + c16 * 16) = *(const u32x4*)(VN + (row0 + row) * AW + g * 128 + c16 * 8); }
        __syncthreads();
        f32x16 D0, D1;
#pragma unroll
        for (int e = 0; e < 16; ++e) { D0[e] = 0.f; D1[e] = 0.f; }
        const bf16* wa = WSB + ((size_t)g * 128 + 32 * tt + r) * 128 + 8 * hi;
        const LAS unsigned char* vb = lds + (8 * hi + ((lane & 15) >> 2)) * SM_PITCH + (64 * cp + 16 * ((lane >> 4) & 1) + 4 * (lane & 3)) * 2;
        for (int ks = 0; ks < 2 * tt + 2; ++ks) {
            const bf16x8 a = *(const bf16x8*)(wa + 16 * ks);
            const LAS unsigned char* vk = vb + 16 * ks * SM_PITCH;
            const s16x4 x0 = tr_read(vk), x1 = tr_read(vk + 4 * SM_PITCH), y0 = tr_read(vk + 64), y1 = tr_read(vk + 4 * SM_PITCH + 64);
            const bf16x8 v0 = (bf16x8){x0[0], x0[1], x0[2], x0[3], x1[0], x1[1], x1[2], x1[3]}, v1 = (bf16x8){y0[0], y0[1], y0[2], y0[3], y1[0], y1[1], y1[2], y1[3]};
            D0 = __builtin_amdgcn_mfma_f32_32x32x16_bf16(a, v0, D0, 0, 0, 0);
            D1 = __builtin_amdgcn_mfma_f32_32x32x16_bf16(a, v1, D1, 0, 0, 0);
        }
#pragma unroll
        for (int e = 0; e < 16; ++e) {
            const int t = 32 * tt + (e & 3) + 8 * (e >> 2) + 4 * hi; const float bias = sgu_bs[g * 128 + t];
            const size_t o = (row0 + t) * AW + g * 128 + 64 * cp + r;
            UZ[o] = (bf16)f2bf(bf2f(Ub[o]) * (D0[e] + bias)); UZ[o + 32] = (bf16)f2bf(bf2f(Ub[o + 32]) * (D1[e] + bias));
        }
    }
    __syncthreads();
}


template <class Q> __device__ __forceinline__ void skgemm(LAS unsigned char* lds, const bf16* __restrict__ A, const bf16* __restrict__ Bt, int row0, int K, const Q& q) {
    int tid = threadIdx.x; asm volatile("" : "+v"(tid));
    const int lane = tid & 63, w = __builtin_amdgcn_readfirstlane(tid >> 6), fr = lane & 15, fq = lane >> 4;
    const int kw = K >> 3, k0 = w * kw;
    for (int tile = blockIdx.x; tile < 256; tile += gridDim.x) {
        const int tm = tile >> 4, tn = tile & 15;
        f32x4 acc[4][4];
#pragma unroll
        for (int i = 0; i < 4; ++i)
#pragma unroll
            for (int j = 0; j < 4; ++j) acc[i][j] = (f32x4){0.f, 0.f, 0.f, 0.f};
        const bf16* ap = A + (size_t)(row0 + 64 * tm + fr) * K + k0;
        const bf16* bp = Bt + (size_t)(64 * tn + fr) * K + k0;
        const int NS = kw >> 5, NP2 = 2 * (NS >> 1);
#define SK_OFF(s_) (((s_) < NP2) ? (((s_) >> 1) * 64 + 16 * fq + ((s_) & 1) * 8) : ((s_) * 32 + 8 * fq))
        bf16x8 a[4], b[4];
        { const int o0 = SK_OFF(0);
#pragma unroll
        for (int i = 0; i < 4; ++i) { a[i] = *(const bf16x8*)(ap + (size_t)16 * i * K + o0); b[i] = *(const bf16x8*)(bp + (size_t)16 * i * K + o0); } }
        for (int st = 0; st < NS; ++st) {
            bf16x8 an[4], bn[4];
            const int sn = (st + 1 < NS) ? st + 1 : st; const int on = SK_OFF(sn);
#pragma unroll
            for (int i = 0; i < 4; ++i) { an[i] = *(const bf16x8*)(ap + (size_t)16 * i * K + on); bn[i] = *(const bf16x8*)(bp + (size_t)16 * i * K + on); }
#pragma unroll
            for (int i = 0; i < 4; ++i)
#pragma unroll
                for (int j = 0; j < 4; ++j) acc[i][j] = __builtin_amdgcn_mfma_f32_16x16x32_bf16(b[j], a[i], acc[i][j], 0, 0, 0);
#pragma unroll
            for (int i = 0; i < 4; ++i) { a[i] = an[i]; b[i] = bn[i]; }
        }
#undef SK_OFF
        __syncthreads();
        LAS float* P = (LAS float*)lds + w * (64 * 68);
#pragma unroll
        for (int i = 0; i < 4; ++i)
#pragma unroll
            for (int j = 0; j < 4; ++j) *(LAS f32x4*)(P + (16 * i + fr) * 68 + 16 * j + 4 * fq) = acc[i][j];
        __syncthreads();
#pragma unroll
        for (int i2 = 0; i2 < 2; ++i2) {
            const int qd = lane + 64 * i2, rl = 8 * w + (qd >> 4), c4 = (qd & 15) * 4;
            f32x4 sum = (f32x4){0.f, 0.f, 0.f, 0.f};
#pragma unroll
            for (int pp = 0; pp < 8; ++pp) sum += *(const LAS f32x4*)((const LAS float*)lds + pp * (64 * 68) + rl * 68 + c4);
            const int row = row0 + 64 * tm + rl;
            float ss = q.quad(row, 64 * tn + c4, sum, q.rowinit(row, 0));
            if constexpr (Q::NEED_SS) { ss = sum16(ss); if ((lane & 15) == 0) q.rowsum(row, ss); }
        }
    }
    __syncthreads();
}
template <class Q> __device__ __forceinline__ void gemm_narrow(LAS unsigned char* lds, const bf16* A, const bf16* Bt, int K, const Q& q) {
    gemm8<false>(lds, A, Bt, TP, DM, K, q);
    skgemm(lds, A, Bt, TP, K, q);
}

template <int MODE> __device__ __forceinline__ int cmap(int n) {
    if (MODE == 0) return n;
    if (MODE == 1) { const int p = n >> 8, j = n & 255; return j < 128 ? 128 * p + j : DFF + 128 * p + (j - 128); }
    if (n < 1024) return n;
    if (n < 1280) return 1408 + (n - 1024);
    if (n < 1664) return 1024 + (n - 1280);
    if (n < 1696) return n;
    if (n < 1792) return -1;
    return 1696 + (n - 1792);
}
template <int MODE> __device__ __forceinline__ void conv_w(const float* __restrict__ src, int K, int Nsrc, bf16* __restrict__ dst, int Ndst, const float* __restrict__ gain, long gt, long ngt) {
    const long total = (long)K * Ndst;
    for (long i = gt; i < total; i += ngt) {
        const int k = (int)(i / Ndst), n = (int)(i % Ndst);
        const int c = cmap<MODE>(n);
        float v = 0.f;
        if (c >= 0) { v = src[(size_t)k * Nsrc + c]; if (gain) v *= gain[k]; }
        dst[(size_t)n * K + k] = (bf16)f2bf(v);
    }
}


template <int MODE> __device__ __forceinline__ void conv_wt(const float* __restrict__ src, int K, int Nsrc, bf16* __restrict__ dst, int Ndst, const float* __restrict__ gain, LAS float* scr, int gw, int ngw, int lane) {
    const int nblk = Ndst / 32, nitems = (K / 64) * nblk;
    for (int it = gw; it < nitems; it += ngw) {
        const int kb = it / nblk, nb = it - kb * nblk, k0 = 64 * kb, n0 = 32 * nb;
        const int c0 = cmap<MODE>(n0);
        f32x4 v[8]; float gv[8];
#pragma unroll
        for (int i = 0; i < 8; ++i) { const int kk = 8 * i + (lane >> 3);
            v[i] = (c0 >= 0) ? *(const f32x4*)(src + (size_t)(k0 + kk) * Nsrc + c0 + 4 * (lane & 7)) : (f32x4){0.f, 0.f, 0.f, 0.f};
            gv[i] = gain ? gain[k0 + kk] : 1.0f; }
#pragma unroll
        for (int i = 0; i < 8; ++i) { const int kk = 8 * i + (lane >> 3); LAS float* sp = scr + kk * 33 + 4 * (lane & 7);
            sp[0] = v[i][0] * gv[i]; sp[1] = v[i][1] * gv[i]; sp[2] = v[i][2] * gv[i]; sp[3] = v[i][3] * gv[i]; }
        asm volatile("s_waitcnt lgkmcnt(0)" ::: "memory");
        const int c = lane & 7;
#pragma unroll
        for (int j = 0; j < 4; ++j) { const int n = (lane >> 3) + 8 * j; const LAS float* sp = scr + (8 * c) * 33 + n;
            u32x4 o; o.x = pk2(sp[0 * 33], sp[1 * 33]); o.y = pk2(sp[2 * 33], sp[3 * 33]); o.z = pk2(sp[4 * 33], sp[5 * 33]); o.w = pk2(sp[6 * 33], sp[7 * 33]);
            *(u32x4*)(dst + (size_t)(n0 + n) * K + k0 + 8 * c) = o; }
        asm volatile("s_waitcnt lgkmcnt(0)" ::: "memory");
    }
}

__device__ __forceinline__ void rope_cs_calc(int pos, int i, float& c, float& s) {
    const double inv = exp2(-(double)i * (13.287712379549449 / 16.0));
    const double ang = (double)((float)pos * (float)inv);
    c = (float)cos(ang); s = (float)sin(ang);
}
constexpr int NROPE = SEQ + DECS;
__device__ __forceinline__ int tok_pos(int r) { return r < TP ? (r & (SEQ - 1)) : PAST + ((r - TP) & (DECS - 1)); }
__device__ __forceinline__ int rope_row(int r) { return r < TP ? (r & (SEQ - 1)) : SEQ + ((r - TP) & (DECS - 1)); }

__global__ void __launch_bounds__(NTHREADS, 2) __attribute__((target("no-packed-fp32-ops"))) fwd(Args a) {
    extern __shared__ __attribute__((aligned(16))) unsigned char lds[];
#define PHASE_IDS() int tid = threadIdx.x; asm volatile("" : "+v"(tid)); const int lane = tid & 63, wave = __builtin_amdgcn_readfirstlane(tid >> 6); \
    const int gw = blockIdx.x * NWAVES + wave, ngw = gridDim.x * NWAVES; const long gt = (long)blockIdx.x * NTHREADS + tid, ngt = (long)gridDim.x * NTHREADS; (void)lane; (void)gw; (void)ngw; (void)gt; (void)ngt
    typedef const __attribute__((address_space(4))) Args* ArgsCP;
    ArgsCP AP = (ArgsCP)__builtin_amdgcn_kernarg_segment_ptr();
#define RELOAD_ARGS() asm volatile("" : "+s"(AP))
    volatile LAS unsigned* MISC = (volatile LAS unsigned*)((LAS unsigned char*)lds + MISC_OFF);
    if (threadIdx.x < 32) MISC[threadIdx.x] = 0u;
    __syncthreads();
    XcdBarrier bar = xcd_barrier_post((unsigned*)(AP->ws + WS_CTL) + CTL_BAR_WORD, MISC + 8);
#define GRID_BAR() do { xcd_barrier(bar); RELOAD_ARGS(); } while (0)
    LAS unsigned char* L = (LAS unsigned char*)lds;

#define x_p (AP->in[0])
#define x_s (AP->in[1])
#define cache_ckv (AP->in[2])
#define cache_kr (AP->in[3])
#define pt (AP->pt)
#define p_p (AP->in[5])
#define p_s (AP->in[6])
#define ffn1_norm (AP->in[7])
#define ffn1_w_in (AP->in[8])
#define ffn1_w_out (AP->in[9])
#define mix_norm (AP->in[10])
#define w_in (AP->in[11])
#define qa_norm (AP->in[12])
#define kva_norm (AP->in[13])
#define w_uq (AP->in[14])
#define w_ukv (AP->in[15])
#define q_norm (AP->in[16])
#define k_norm (AP->in[17])
#define sgu_g (AP->in[18])
#define sgu_b (AP->in[19])
#define sgu_ws (AP->in[20])
#define sgu_bs (AP->in[21])
#define w_a_out (AP->in[22])
#define w_b_out (AP->in[23])
#define w_o (AP->in[24])
#define ffn2_norm (AP->in[25])
#define ffn2_w_in (AP->in[26])
#define ffn2_w_out (AP->in[27])
#define ple_norm (AP->in[28])
#define ple_w_gate (AP->in[29])
#define ple_w_proj (AP->in[30])
#define out (AP->out)
#define W1T ((bf16*)(ws + WS_W1T))
#define W2T ((bf16*)(ws + WS_W2T))
#define WINT ((bf16*)(ws + WS_WINT))
#define WUQT ((bf16*)(ws + WS_WUQT))
#define WUKVT ((bf16*)(ws + WS_WUKVT))
#define WAT ((bf16*)(ws + WS_WAT))
#define WBT ((bf16*)(ws + WS_WBT))
#define WOT ((bf16*)(ws + WS_WOT))
#define W3T ((bf16*)(ws + WS_W3T))
#define W4T ((bf16*)(ws + WS_W4T))
#define WGT ((bf16*)(ws + WS_WGT))
#define WPT ((bf16*)(ws + WS_WPT))
#define WSB ((bf16*)(ws + WS_WSB))
#define XB ((bf16*)(ws + WS_XB))
#define HB ((bf16*)(ws + WS_HB))
#define ACT ((bf16*)(ws + WS_ACT))
#define Ub ((bf16*)(ws + WS_U))
#define Vb ((bf16*)(ws + WS_V))
#define VN ((bf16*)(ws + WS_VN))
#define RAW ((float*)(ws + WS_RAW))
#define SG ((bf16*)(ws + WS_SG))
#define CKV ((bf16*)(ws + WS_CKV))
#define KR ((bf16*)(ws + WS_KR))
#define CQN ((bf16*)(ws + WS_CQN))
#define UZ ((bf16*)(ws + WS_UZ))
#define QRAW ((bf16*)(ws + WS_QRAW))
#define Qn ((bf16*)(ws + WS_Q))
#define KVR ((bf16*)(ws + WS_KVR))
#define KN ((bf16*)(ws + WS_KN))
#define Ob ((bf16*)(ws + WS_O))
#define MXF ((bf16*)(ws + WS_MXF))
#define MX ((bf16*)(ws + WS_MX))
#define PP ((bf16*)(ws + WS_PP))
#define PB ((bf16*)(ws + WS_PB))
#define SSX ((float*)(ws + WS_SSX))
#define OPART ((float*)(ws + WS_KPAST))
#define LPART ((float*)(ws + WS_KPAST + 32 * MiB))
#define SSH1 ((float*)(ws + CTL_SSH1))
#define SSH2 ((float*)(ws + CTL_SSH2))
#define SSH3 ((float*)(ws + CTL_SSH3))
#define Y (out + O_Y)
#define ROPET ((f32x2_t*)(ws + WS_ROPE))
#define GQKT ((float*)(ws + WS_GQK))
#define ws (AP->ws)

    { PHASE_IDS();
    LAS float* scr = (LAS float*)(L + wave * 8448);
    conv_wt<1>(ffn1_w_in, DM, NFF, W1T, NFF, ffn1_norm, scr, (gw + ngw - (0 % ngw)) % ngw, ngw, lane);
    conv_wt<0>(ffn1_w_out, DFF, DM, W2T, DM, nullptr, scr, (gw + ngw - (2816 % ngw)) % ngw, ngw, lane);
    conv_wt<2>(w_in, DM, INC, WINT, INP, mix_norm, scr, (gw + ngw - (4224 % ngw)) % ngw, ngw, lane);
    conv_wt<0>(w_uq, QL, NH * QKH, WUQT, NH * QKH, nullptr, scr, (gw + ngw - (6144 % ngw)) % ngw, ngw, lane);
    conv_wt<0>(w_ukv, KVL, NH * 128, WUKVT, NH * 128, nullptr, scr, (gw + ngw - (6288 % ngw)) % ngw, ngw, lane);
    conv_wt<0>(w_a_out, AW, DM, WAT, DM, nullptr, scr, (gw + ngw - (6416 % ngw)) % ngw, ngw, lane);
    conv_wt<0>(w_b_out, AW, DM, WBT, DM, nullptr, scr, (gw + ngw - (6672 % ngw)) % ngw, ngw, lane);
    conv_wt<0>(w_o, DM, DM, WOT, DM, nullptr, scr, (gw + ngw - (6928 % ngw)) % ngw, ngw, lane);
    conv_wt<1>(ffn2_w_in, DM, NFF, W3T, NFF, ffn2_norm, scr, (gw + ngw - (7440 % ngw)) % ngw, ngw, lane);
    conv_wt<0>(ffn2_w_out, DFF, DM, W4T, DM, nullptr, scr, (gw + ngw - (10256 % ngw)) % ngw, ngw, lane);
    conv_wt<0>(ple_w_gate, DM, DM, WGT, DM, ple_norm, scr, (gw + ngw - (11664 % ngw)) % ngw, ngw, lane);
    conv_wt<0>(ple_w_proj, PLE, DM, WPT, DM, nullptr, scr, (gw + ngw - (12176 % ngw)) % ngw, ngw, lane);
    if (gt < QKH) GQKT[gt] = q_norm[gt] * k_norm[gt];
    for (int i = (int)gt; i < NROPE * 16; i += (int)ngt) { const int row = i >> 4; float c, s_; rope_cs_calc(row < SEQ ? row : PAST + (row - SEQ), i & 15, c, s_); ROPET[i] = (f32x2_t){c, s_}; }
    for (int i = (int)gt; i < 4 * 128 * 128; i += (int)ngt) WSB[i] = ((i & 127) <= ((i >> 7) & 127)) ? (bf16)f2bf(sgu_ws[i]) : (bf16)0;
#pragma unroll 2
    for (int r = gw; r < T; r += ngw) {
        const float* xr = (r < TP) ? x_p + (size_t)r * DM : x_s + (size_t)(r - TP) * DM;
        float s = 0.f;
#pragma unroll
        for (int j = 0; j < 4; ++j) { const f32x4 v = *(const f32x4*)(xr + 256 * j + 4 * lane); s += (v[0] * v[0] + v[1] * v[1]) + (v[2] * v[2] + v[3] * v[3]);
            st_bf4(XB + (size_t)r * DM + 256 * j + 4 * lane, v[0], v[1], v[2], v[3]); }
        s = wave_sum(s); if (lane == 0) SSX[r] = s;
        const float* pr = (r < TP) ? p_p + (size_t)r * PLE : p_s + (size_t)(r - TP) * PLE;
        const f32x4 pv = *(const f32x4*)(pr + 4 * lane); st_bf4(PB + (size_t)r * PLE + 4 * lane, pv[0], pv[1], pv[2], pv[3]);
    }
    }
    GRID_BAR();

    { EpiSwiglu E{ACT, L}; gemm8s<true>(L, XB, W1T, T, NFF, DM, E, SSX); }
    GRID_BAR();
    { EpiResid E{XB, HB, SSH1, 0.5f}; gemm_narrow(L, ACT, W2T, DFF, E); }
    GRID_BAR();
    { PHASE_IDS();
    { EpiIn E{Ub, Vb, RAW, SG, L}; gemm8s<false>(L, HB, WINT, T, INP, DM, E, SSH1); }
    { EpiBf E{PP, DM}; gemm_narrow(L, PB, WPT, PLE, E); }
    }
    GRID_BAR();

    { PHASE_IDS();
    for (int r = gw; r < T; r += ngw) {
        const float* raw = RAW + (size_t)r * 768;
        {
            const f32x4 v = *(const f32x4*)(raw + 4 * lane);
            const float ss = wave_sum((v[0] * v[0] + v[1] * v[1]) + (v[2] * v[2] + v[3] * v[3]));
            const float rinv = rsqrtf(ss * (1.0f / KVL) + EPS);
            const f32x4 g = *(const f32x4*)(kva_norm + 4 * lane);
            const f32x4 c = v * rinv * g;
            float* o = (r < TP) ? out + O_CKVP + (size_t)r * KVL : out + O_CKVS + (size_t)(r - TP) * KVL;
            *(f32x4*)(o + 4 * lane) = c;
            st_bf4(CKV + (size_t)r * KVL + 4 * lane, c[0], c[1], c[2], c[3]);
        }
        {
            if (lane < 16) {
                const float x1 = raw[640 + lane], x2 = raw[656 + lane]; const f32x2_t cs = ROPET[rope_row(r) * 16 + lane]; const float c = cs.x, s = cs.y;
                const float o1 = x1 * c - x2 * s, o2 = x1 * s + x2 * c;
                float* o = (r < TP) ? out + O_KRP + (size_t)r * ROPE : out + O_KRS + (size_t)(r - TP) * ROPE;
                o[lane] = o1; o[16 + lane] = o2;
                KR[(size_t)r * ROPE + lane] = (bf16)f2bf(o1); KR[(size_t)r * ROPE + 16 + lane] = (bf16)f2bf(o2);
            }
        }
        {
            float v[6]; float ss = 0.f;
#pragma unroll
            for (int e = 0; e < 6; ++e) { v[e] = raw[256 + 6 * lane + e]; ss += v[e] * v[e]; }
            ss = wave_sum(ss); const float rinv = rsqrtf(ss * (1.0f / QL) + EPS);
#pragma unroll
            for (int e = 0; e < 6; ++e) CQN[(size_t)r * QL + 6 * lane + e] = (bf16)f2bf(v[e] * rinv * qa_norm[6 * lane + e]);
        }
        {
            const u32x4 w = *(const u32x4*)(Vb + (size_t)r * AW + 8 * lane); float v[8]; unpack8(w, v);
            float s = 0.f;
#pragma unroll
            for (int e = 0; e < 8; ++e) s += v[e];
            const float mean = wave_sum(s) * (1.0f / AW); float q = 0.f;
#pragma unroll
            for (int e = 0; e < 8; ++e) { v[e] -= mean; q += v[e] * v[e]; }
            const float rstd = rsqrtf(wave_sum(q) * (1.0f / AW) + EPS);
#pragma unroll
            for (int e = 0; e < 8; ++e) v[e] = v[e] * rstd * sgu_g[8 * lane + e] + sgu_b[8 * lane + e];
            u32x4 o; o.x = pk2(v[0], v[1]); o.y = pk2(v[2], v[3]); o.z = pk2(v[4], v[5]); o.w = pk2(v[6], v[7]);
            *(u32x4*)(VN + (size_t)r * AW + 8 * lane) = o;
            if (r >= TP) { float* o32 = out + O_VNS + (size_t)(r - TP) * AW + 8 * lane;
                *(f32x4*)o32 = (f32x4){v[0], v[1], v[2], v[3]}; *(f32x4*)(o32 + 4) = (f32x4){v[4], v[5], v[6], v[7]}; }
        }
    }
    }
    GRID_BAR();

    { PHASE_IDS();
    for (int r = TP + gw; r < T; r += ngw) {
        const int tc = (r < TP) ? (r & 127) : ((r - TP) & 7); const int start = r - tc; const int g = lane >> 4;
        float z[8];
#pragma unroll
        for (int e = 0; e < 8; ++e) z[e] = 0.f;
        const float* wrow = sgu_ws + ((size_t)g * 128 + tc) * 128;
        for (int s = 0; s <= tc; ++s) {
            const float w = wrow[s]; const u32x4 vw = *(const u32x4*)(VN + (size_t)(start + s) * AW + 8 * lane); float v[8]; unpack8(vw, v);
#pragma unroll
            for (int e = 0; e < 8; ++e) z[e] += w * v[e];
        }
        const float bsv = sgu_bs[g * 128 + tc];
        const u32x4 uw = *(const u32x4*)(Ub + (size_t)r * AW + 8 * lane); float u[8]; unpack8(uw, u);
#pragma unroll
        for (int e = 0; e < 8; ++e) z[e] = (z[e] + bsv) * u[e];
        u32x4 o; o.x = pk2(z[0], z[1]); o.y = pk2(z[2], z[3]); o.z = pk2(z[4], z[5]); o.w = pk2(z[6], z[7]);
        *(u32x4*)(UZ + (size_t)r * AW + 8 * lane) = o;
    }
    }
    spatial_mix(L, VN, WSB, sgu_bs, Ub, UZ);
    {
    { EpiBf E{QRAW, NH * QKH}; gemm8<false>(L, CQN, WUQT, T, NH * QKH, QL, E); }
    { EpiBf E{KVR, 1024}; gemm_narrow(L, CKV, WUKVT, KVL, E); }
    }
    GRID_BAR();

    prompt_attn(L, QRAW, KVR, KR, ROPET, GQKT, Ob);
    { DecodeArgs D{cache_ckv, cache_kr, pt, QRAW, ROPET, GQKT, WUKVT, out + O_CKVS, out + O_KRS, (const float*)(ws + CTL_ZEROS), OPART, LPART}; decode_attn(L, D); }
    GRID_BAR();

    decode_combine(L, OPART, LPART, WUKVT, Ob);
    { EpiGateA E{MXF, SG}; gemm_narrow(L, UZ, WAT, AW, E); }
    GRID_BAR();
    { EpiGateB E{MXF, SG, MX}; gemm_narrow(L, Ob, WBT, AW, E); }
    GRID_BAR();
    { EpiResid E{HB, HB, SSH2, 1.0f}; gemm_narrow(L, MX, WOT, DM, E); }
    GRID_BAR();
    { EpiSwiglu E{ACT, L}; gemm8s<true>(L, HB, W3T, T, NFF, DM, E, SSH2); }
    GRID_BAR();
    { EpiResid E{HB, HB, SSH3, 0.5f}; gemm_narrow(L, ACT, W4T, DFF, E); }
    GRID_BAR();
    { EpiPleT<true> E{Y, HB, PP, SSH3, L}; gemm8s<false>(L, HB, WGT, TP, DM, DM, E, SSH3); }
    { EpiPleT<false> E{Y, HB, PP, SSH3, L}; skgemm(L, HB, WGT, TP, DM, E); }
}

#undef x_p
#undef x_s
#undef cache_ckv
#undef cache_kr
#undef pt
#undef p_p
#undef p_s
#undef ffn1_norm
#undef ffn1_w_in
#undef ffn1_w_out
#undef mix_norm
#undef w_in
#undef qa_norm
#undef kva_norm
#undef w_uq
#undef w_ukv
#undef q_norm
#undef k_norm
#undef sgu_g
#undef sgu_b
#undef sgu_ws
#undef sgu_bs
#undef w_a_out
#undef w_b_out
#undef w_o
#undef ffn2_norm
#undef ffn2_w_in
#undef ffn2_w_out
#undef ple_norm
#undef ple_w_gate
#undef ple_w_proj
#undef out
#undef W1T
#undef W2T
#undef WINT
#undef WUQT
#undef WUKVT
#undef WAT
#undef WBT
#undef WOT
#undef W3T
#undef W4T
#undef WGT
#undef WPT
#undef WSB
#undef XB
#undef HB
#undef ACT
#undef Ub
#undef Vb
#undef VN
#undef RAW
#undef SG
#undef CKV
#undef KR
#undef CQN
#undef UZ
#undef QRAW
#undef Qn
#undef KVR
#undef KN
#undef Ob
#undef MXF
#undef MX
#undef PP
#undef PB
#undef SSX
#undef OPART
#undef LPART
#undef SSH1
#undef SSH2
#undef SSH3
#undef Y
#undef ROPET
#undef GQKT
#undef ws
#undef RELOAD_ARGS
#undef GRID_BAR
#undef PHASE_IDS
extern "C" void kernel_launch(void* const* d_in, const int* in_sizes, int n_in, void* d_out, int out_size, void* d_ws, size_t ws_size, hipStream_t stream) {
    static int grid = 0;
    if (grid == 0) {
        if (n_in != 31 || (size_t)out_size != O_END || ws_size < WS_END) { fprintf(stderr, "kernel_launch: unexpected shapes: n_in %d out %d ws %zu\n", n_in, out_size, ws_size); grid = -1; return; }
        int dev = 0, cus = 0, per_cu = 0;
        if (hipGetDevice(&dev) != hipSuccess || hipDeviceGetAttribute(&cus, hipDeviceAttributeMultiprocessorCount, dev) != hipSuccess) { grid = -1; return; }
        if (hipFuncSetAttribute((const void*)fwd, hipFuncAttributeMaxDynamicSharedMemorySize, LDS_BYTES) != hipSuccess) { fprintf(stderr, "kernel_launch: hipFuncSetAttribute failed\n"); grid = -1; return; }
        if (hipOccupancyMaxActiveBlocksPerMultiprocessor(&per_cu, (const void*)fwd, NTHREADS, LDS_BYTES) != hipSuccess || per_cu < 1) { fprintf(stderr, "kernel_launch: occupancy query says %d\n", per_cu); grid = -1; (void)hipGetLastError(); return; }
        grid = cus;
    }
    if (grid < 0) return;
    (void)hipMemsetAsync((char*)d_ws + WS_CTL, 0, CTL_ZERO_BYTES, stream);
    Args a{};
    for (int i = 0; i < 31; ++i) a.in[i] = (const float*)d_in[i];
    a.pt = (const int*)d_in[4]; a.out = (float*)d_out; a.ws = (unsigned char*)d_ws;
    hipLaunchKernelGGL(fwd, dim3(grid), dim3(NTHREADS), LDS_BYTES, stream, a);
}
```
